# Optimizing an MI355X kernel written in HIP

```python
import math
import jax, jax.numpy as jnp
from jax import lax
import numpy as np

D_MODEL = 2048
BATCH = 8
SEQ = 4096
DEPTH = 1

HEAD_DIM = 128
ATTN_HEADS = D_MODEL // (2 * HEAD_DIM)
ATTN_W = ATTN_HEADS * HEAD_DIM
HY_GROUP_DIM = 128
HY_GROUPS = D_MODEL // (2 * HY_GROUP_DIM)
HY_W = HY_GROUPS * HY_GROUP_DIM
IN_W = 3 * ATTN_W + 3 * HY_W
ATTN_PATTERNS = ((128, 1), (512, 4), (2048, 16))
N_BUCKETS = 32
REL_MAX_DIST = 1024
HY_EMB = 33
HY_FILTER_WIDTH = 64
HY_INNER = 2
HY_SHORT_CONV = 3
HY_DECAY_MIN = 3.07
HY_DECAY_MAX = 15.35
FFN_HIDDEN = ((8 * D_MODEL // 3 + 255) // 256) * 256
PLE_DIM = 256
EPS = 1e-6
NEG = -1e30

kernel_name = "hybrid_hyena_dilated_attn_encoder_layer"


def rms_norm(x, gain):
    xf = x.astype(jnp.float32)
    y = xf * lax.rsqrt(jnp.mean(xf * xf, axis=-1, keepdims=True) + EPS)
    return (y * gain.astype(jnp.float32)).astype(x.dtype)


def group_rms_norm(y, gain, n_groups):
    B, S, W = y.shape
    yg = rms_norm(y.reshape(B, S, n_groups, W // n_groups), gain.reshape(n_groups, W // n_groups))
    return yg.reshape(B, S, W)


def t5_bucket(rel):
    half = N_BUCKETS // 2
    exact = half // 2
    n = jnp.abs(rel)
    large = exact + (jnp.log(jnp.maximum(n, 1).astype(jnp.float32) / exact)
                     / math.log(REL_MAX_DIST / exact) * (half - exact)).astype(jnp.int32)
    large = jnp.minimum(large, half - 1)
    return jnp.where(rel > 0, half, 0) + jnp.where(n < exact, n, large)


def dilated_window_attention(q, k, v, rel_bias, window, dilation):
    B, S, H, Dh = q.shape
    d = dilation
    n = (window // 2) // d
    Q = n
    Ls = S // d
    nb = -(-Ls // Q)
    Lp = nb * Q

    def strided(t):
        return t.reshape(B, Ls, d, H, Dh).transpose(0, 2, 3, 1, 4)

    qs = jnp.pad(strided(q), ((0, 0), (0, 0), (0, 0), (0, Lp - Ls), (0, 0)))
    pad_kv = ((0, 0), (0, 0), (0, 0), (Q, Lp - Ls + Q), (0, 0))
    ks = jnp.pad(strided(k), pad_kv).reshape(B, d, H, nb + 2, Q, Dh)
    vs = jnp.pad(strided(v), pad_kv).reshape(B, d, H, nb + 2, Q, Dh)
    qb = qs.reshape(B, d, H, nb, Q, Dh)
    kb = jnp.concatenate([ks[:, :, :, :-2], ks[:, :, :, 1:-1], ks[:, :, :, 2:]], axis=4)
    vb = jnp.concatenate([vs[:, :, :, :-2], vs[:, :, :, 1:-1], vs[:, :, :, 2:]], axis=4)

    qi = jnp.arange(Q)[:, None]
    kj = jnp.arange(3 * Q)[None, :]
    rel = kj - Q - qi
    band = jnp.abs(rel) <= n
    j_abs = (jnp.arange(nb)[:, None] - 1) * Q + jnp.arange(3 * Q)[None, :]
    valid = (j_abs >= 0) & (j_abs < Ls)
    mask = band[None] & valid[:, None, :]
    bias = jnp.moveaxis(rel_bias.astype(jnp.float32)[t5_bucket(rel * d)], -1, 0)

    s = jnp.einsum('brhnqc,brhnkc->brhnqk', qb, kb).astype(jnp.float32) * (Dh ** -0.5)
    s = jnp.where(mask, s + bias[:, None], NEG)
    m = jnp.max(s, axis=-1, keepdims=True)
    e = jnp.exp(s - m)
    l = jnp.sum(e, axis=-1)
    o = jnp.einsum('brhnqk,brhnkc->brhnqc', e.astype(vb.dtype), vb).astype(jnp.float32) / l[..., None]
    lse = m[..., 0] + jnp.log(l)

    o = o.reshape(B, d, H, Lp, Dh)[:, :, :, :Ls].transpose(0, 3, 1, 2, 4).reshape(B, S, H, Dh)
    lse = lse.reshape(B, d, H, Lp)[:, :, :, :Ls].transpose(0, 3, 1, 2).reshape(B, S, H)
    return o, lse


def hyena_filter(L, w1, b1, wi, bi, wo, freq, decay):
    f32 = jnp.float32
    pos = jnp.arange(L, dtype=f32)
    t = pos / max(L - 1, 1)
    bands = (HY_EMB - 1) // 2
    fr = jnp.linspace(1e-4, bands - 1, bands, dtype=f32)
    ang = (2.0 * math.pi / L) * pos[:, None] * fr[None, :]
    z = jnp.concatenate([t[:, None], jnp.cos(ang), -jnp.sin(ang)], axis=-1)
    fq = freq.astype(f32)
    hdn = jnp.sin(fq * (z @ w1.astype(f32) + b1.astype(f32)))
    for j in range(HY_INNER):
        hdn = jnp.sin(fq * (hdn @ wi[j].astype(f32) + bi[j].astype(f32)))
    filt = hdn @ wo.astype(f32)
    offs = jnp.abs(pos - (L // 2)) / (L / 2)
    return filt * jnp.exp(-offs[:, None] * jnp.abs(decay.astype(f32))[None, :])


def centred_long_conv(v, filt):
    L = v.shape[1]
    vf = jnp.fft.rfft(v.astype(jnp.float32), n=2 * L, axis=1)
    hf = jnp.fft.rfft(filt, n=2 * L, axis=0)
    y = jnp.fft.irfft(vf * hf[None], n=2 * L, axis=1)
    return y[:, L // 2: L // 2 + L]


def short_conv(u, w, b):
    C = u.shape[-1]
    y = lax.conv_general_dilated(u, w[:, None, :].astype(u.dtype), window_strides=(1,),
                                 padding=[(1, 1)], dimension_numbers=('NWC', 'WIO', 'NWC'),
                                 feature_group_count=C)
    return y + b.astype(u.dtype)


def setup_inputs(seed: int = 0) -> dict:
    key = jax.random.key(seed)
    ks = jax.random.split(key, 32)
    f32 = jnp.float32
    nrm = lambda k, shape, scale: jax.random.normal(k, shape, f32) * scale
    gain = lambda k, shape: 1.0 + 0.05 * jax.random.normal(k, shape, f32)
    L = DEPTH
    return {
        "x": jax.random.normal(ks[0], (BATCH, SEQ, D_MODEL), f32),
        "p": jax.random.normal(ks[1], (DEPTH, BATCH, SEQ, PLE_DIM), f32),
        "rel_bias": nrm(ks[2], (N_BUCKETS, ATTN_HEADS), 0.5),
        "norm1": gain(ks[3], (L, D_MODEL)),
        "w_in": nrm(ks[4], (L, D_MODEL, IN_W), D_MODEL ** -0.5),
        "q_norm": gain(ks[5], (L, HEAD_DIM)),
        "k_norm": gain(ks[6], (L, HEAD_DIM)),
        "conv_w": nrm(ks[7], (L, HY_SHORT_CONV, 3 * HY_W), HY_SHORT_CONV ** -0.5),
        "conv_b": nrm(ks[8], (L, 3 * HY_W), 0.02),
        "hy_w1": nrm(ks[9], (L, HY_EMB, HY_FILTER_WIDTH), HY_EMB ** -0.5),
        "hy_b1": nrm(ks[10], (L, HY_FILTER_WIDTH), 0.1),
        "hy_wi": nrm(ks[11], (L, HY_INNER, HY_FILTER_WIDTH, HY_FILTER_WIDTH), HY_FILTER_WIDTH ** -0.5),
        "hy_bi": nrm(ks[12], (L, HY_INNER, HY_FILTER_WIDTH), 0.1),
        "hy_wo": nrm(ks[13], (L, HY_FILTER_WIDTH, HY_W), HY_FILTER_WIDTH ** -0.5),
        "hy_freq": gain(ks[14], (L, HY_FILTER_WIDTH)),
        "hy_decay": jnp.exp(jax.random.uniform(ks[15], (L, HY_W), f32,
                                                math.log(HY_DECAY_MIN), math.log(HY_DECAY_MAX))),
        "hy_bias": nrm(ks[16], (L, HY_W), 1.0),
        "attn_out_norm": gain(ks[17], (L, ATTN_W)),
        "hy_out_norm": gain(ks[18], (L, HY_W)),
        "w_out": nrm(ks[19], (L, ATTN_W + HY_W, D_MODEL), (ATTN_W + HY_W) ** -0.5),
        "norm2": gain(ks[20], (L, D_MODEL)),
        "w_gu": nrm(ks[21], (L, D_MODEL, 2 * FFN_HIDDEN), D_MODEL ** -0.5),
        "w_down": nrm(ks[22], (L, FFN_HIDDEN, D_MODEL), FFN_HIDDEN ** -0.5),
        "ple_norm": gain(ks[23], (L, D_MODEL)),
        "w_ple_gate": nrm(ks[24], (L, D_MODEL, D_MODEL), D_MODEL ** -0.5),
        "w_ple_proj": nrm(ks[25], (L, PLE_DIM, D_MODEL), PLE_DIM ** -0.5),
        "ple_post_norm": gain(ks[26], (L, D_MODEL)),
    }


def reference(x, p, rel_bias, norm1, w_in, q_norm, k_norm, conv_w, conv_b, hy_w1, hy_b1,
              hy_wi, hy_bi, hy_wo, hy_freq, hy_decay, hy_bias, attn_out_norm, hy_out_norm,
              w_out, norm2, w_gu, w_down, ple_norm, w_ple_gate, w_ple_proj, ple_post_norm):
    B, S, _ = x.shape
    h = x
    for i in range(DEPTH):
        u = rms_norm(h, norm1[i]) @ w_in[i]
        q, k, v, hy = jnp.split(u, [ATTN_W, 2 * ATTN_W, 3 * ATTN_W], axis=-1)

        q = rms_norm(q.reshape(B, S, ATTN_HEADS, HEAD_DIM), q_norm[i])
        k = rms_norm(k.reshape(B, S, ATTN_HEADS, HEAD_DIM), k_norm[i])
        v = v.reshape(B, S, ATTN_HEADS, HEAD_DIM)
        outs, lses = [], []
        for window, dilation in ATTN_PATTERNS:
            o_g, lse_g = dilated_window_attention(q, k, v, rel_bias, window, dilation)
            outs.append(o_g)
            lses.append(lse_g)
        wts = jax.nn.softmax(jnp.stack(lses), axis=0)
        y_att = jnp.einsum('gbsh,gbshc->bshc', wts, jnp.stack(outs))
        y_att = y_att.reshape(B, S, ATTN_W).astype(h.dtype)

        hy = short_conv(hy, conv_w[i], conv_b[i])
        x0, x1, hv = jnp.split(hy, 3, axis=-1)
        filt = hyena_filter(S, hy_w1[i], hy_b1[i], hy_wi[i], hy_bi[i], hy_wo[i], hy_freq[i], hy_decay[i])
        z = (hv * x1).astype(jnp.float32)
        z = centred_long_conv(z, filt) + z * hy_bias[i].astype(jnp.float32)
        y_hy = (z * x0.astype(jnp.float32)).astype(h.dtype)

        y = jnp.concatenate([group_rms_norm(y_att, attn_out_norm[i], ATTN_HEADS),
                             group_rms_norm(y_hy, hy_out_norm[i], HY_GROUPS)], axis=-1)
        h = h + y @ w_out[i]

        a, g = jnp.split(rms_norm(h, norm2[i]) @ w_gu[i], 2, axis=-1)
        h = h + (jax.nn.silu(a) * g) @ w_down[i]

        gate = jax.nn.sigmoid(rms_norm(h, ple_norm[i]) @ w_ple_gate[i])
        e = rms_norm(p[i] @ w_ple_proj[i], ple_post_norm[i])
        h = h + gate * e
    return h
```

```cpp
#include <hip/hip_runtime.h>
#include <hip/hip_cooperative_groups.h>
#include <cstdio>
#include <cstdint>
namespace cg = cooperative_groups;

#ifndef ONE_LAUNCH
#define ONE_LAUNCH 1
#endif

#define LAS __attribute__((address_space(3)))
typedef unsigned short bf16_t;
typedef short bf16x8 __attribute__((ext_vector_type(8)));
typedef short s16x4 __attribute__((ext_vector_type(4)));
typedef float f32x4 __attribute__((ext_vector_type(4)));
typedef unsigned u32x4 __attribute__((ext_vector_type(4)));
typedef unsigned u32x2 __attribute__((ext_vector_type(2)));
typedef u32x4 u32x4_a4 __attribute__((aligned(4)));

__device__ __forceinline__ unsigned cvt_pk_bf16(float lo, float hi) { unsigned r; asm volatile("v_cvt_pk_bf16_f32 %0, %1, %2" : "=v"(r) : "v"(lo), "v"(hi)); return r; }
__device__ __forceinline__ float bf_lo(unsigned w) { return __uint_as_float(w << 16); }
__device__ __forceinline__ float bf_hi(unsigned w) { return __uint_as_float(w & 0xffff0000u); }
__device__ __forceinline__ float dot4(f32x4 a) { return (a[0] * a[0] + a[1] * a[1]) + (a[2] * a[2] + a[3] * a[3]); }

namespace pg8 {
#define PG8_LAS __attribute__((address_space(3)))
constexpr int BM = 256, BK = 64, HALF = 128, HTB = HALF * BK * 2, STAGE_BYTES = 8 * HTB, NXCD = 8, WGM = 8;
__host__ __device__ __forceinline__ int lds_byte(int r, int c) { const int st = (r >> 4) * 2 + (c >> 5), rr = r & 15, cc = c & 31, ob = rr * 64 + cc * 2; return st * 1024 + (ob ^ (((ob >> 9) & 1) << 5)); }
__host__ __device__ __forceinline__ void stage_rc(int b, int& R, int& C) { const int st = b / 1024, sb = b % 1024, swz = sb ^ (((sb >> 9) & 1) << 5); R = (st >> 1) * 16 + swz / 64; C = (st & 1) * 32 + (swz % 64) / 2; }
__host__ __device__ __forceinline__ int perm32(int rho) { const int n = rho >> 4, i = rho & 15; return 8 * (i >> 2) + 4 * n + (i & 3); }
struct Unit { int pm, pn; };
struct Gemm { const bf16_t* A; const bf16_t* Bt; int M, N, K; };
struct StaticOrder {
    int nM, nN, nwg, G, c;
    __host__ __device__ void init(int M, int N, int G_, int c_) { nM = M / BM; nN = N / BM; nwg = nM * nN; G = G_; c = c_; }
    __host__ __device__ bool next(int i, Unit& u) const {
        const long L = (long)i * G + c; if (L >= nwg) return false;
        int wgid = (int)L; { const int q = nwg / NXCD, r = nwg % NXCD, xcd = wgid % NXCD, off = wgid / NXCD; wgid = (xcd < r ? xcd * (q + 1) : r * (q + 1) + (xcd - r) * q) + off; }
        const int nig = WGM * nN, gid = wgid / nig, fm = gid * WGM, gsz = (nM - fm) < WGM ? (nM - fm) : WGM;
        u.pm = fm + ((wgid % nig) % gsz); u.pn = (wgid % nig) / gsz; return true;
    }
};
template <class Epi>
__device__ __forceinline__ void gemm_phase(PG8_LAS unsigned char* lds, PG8_LAS float* xl, const Gemm g, const StaticOrder& S, const Epi& E) {
    const int tid = threadIdx.x, wid = __builtin_amdgcn_readfirstlane(tid >> 6), lane = tid & 63, wr = wid >> 2, wc = wid & 3, fr = lane & 15, fq = lane >> 4;
    const int K = g.K, nt = K / BK;
    unsigned voffA[2], voffB[2];
#pragma unroll
    for (int i = 0; i < 2; ++i) { int R, C; stage_rc(tid * 16 + i * 8192, R, C); const int Rb = (R & ~31) + perm32(R & 31);
        voffA[i] = (unsigned)(R * K + C) * 2u; voffB[i] = (unsigned)(Rb * K + C) * 2u; }
    const size_t kstep = (size_t)(BK * 2);
    const size_t hstep = (size_t)HALF * K * 2;
    const size_t tstep = 2 * hstep;
    const unsigned ldsw = (unsigned)wid * 1024u;
    const int aoff = lds_byte(wr * 64 + fr, fq * 8), boff = lds_byte(wc * 32 + fr, fq * 8);
#define PG8_SA(b, h) (((b) * 2 + (h)) * HTB)
#define PG8_SB(b, h) ((4 + (b) * 2 + (h)) * HTB)
#define PG8_STAGE(bufoff, gbase, voff) do { _Pragma("unroll") for (int _i = 0; _i < 2; ++_i) \
        __builtin_amdgcn_global_load_lds((const unsigned*)((const char*)(gbase) + (voff)[_i]), (PG8_LAS unsigned*)(lds + (bufoff) + ldsw + _i * 8192), 16, 0, 0); } while (0)
#define PG8_LDA(dst, b, h) do { _Pragma("unroll") for (int m = 0; m < 4; ++m) _Pragma("unroll") for (int k = 0; k < 2; ++k) dst[m][k] = *(const PG8_LAS bf16x8*)(lds + PG8_SA(b, h) + aoff + m * 2048 + k * 1024); } while (0)
#define PG8_LDB(dst, b, h) do { _Pragma("unroll") for (int n = 0; n < 2; ++n) _Pragma("unroll") for (int k = 0; k < 2; ++k) dst[n][k] = *(const PG8_LAS bf16x8*)(lds + PG8_SB(b, h) + boff + n * 2048 + k * 1024); } while (0)
#define PG8_MMA(ai, bj, At, Bt) do { __builtin_amdgcn_s_setprio(1); _Pragma("unroll") for (int m = 0; m < 4; ++m) _Pragma("unroll") for (int n = 0; n < 2; ++n) _Pragma("unroll") for (int k = 0; k < 2; ++k) \
        acc[ai][bj][m][n] = __builtin_amdgcn_mfma_f32_16x16x32_bf16(Bt[n][k], At[m][k], acc[ai][bj][m][n], 0, 0, 0); __builtin_amdgcn_s_setprio(0); } while (0)
#define PG8_WAIT_V(n) asm volatile("s_waitcnt vmcnt(" #n ")" ::: "memory")
#define PG8_WAIT_L(n) asm volatile("s_waitcnt lgkmcnt(" #n ")" ::: "memory")
#define PG8_BAR __builtin_amdgcn_s_barrier()
#define PG8_SCHED __builtin_amdgcn_sched_barrier(0)
    Unit cur, nxt; int ui = 0;
    if (!S.next(0, cur)) return;
    f32x4 acc[2][2][4][2];
#pragma unroll
    for (int a = 0; a < 2; ++a)
#pragma unroll
        for (int b = 0; b < 2; ++b)
#pragma unroll
            for (int m = 0; m < 4; ++m)
#pragma unroll
                for (int n = 0; n < 2; ++n) acc[a][b][m][n] = (f32x4){0.f, 0.f, 0.f, 0.f};
    bf16x8 At[4][2], B0[2][2], B1[2][2];
    const char* cA = (const char*)g.A + (size_t)cur.pm * tstep; const char* cB = (const char*)g.Bt + (size_t)cur.pn * tstep;
    PG8_STAGE(PG8_SB(0, 0), cB, voffB); PG8_STAGE(PG8_SB(0, 1), cB + hstep, voffB); PG8_STAGE(PG8_SA(0, 0), cA, voffA); PG8_STAGE(PG8_SA(0, 1), cA + hstep, voffA);
    if (wr == 1) PG8_BAR;
    PG8_WAIT_V(2); PG8_BAR;
    PG8_STAGE(PG8_SB(1, 0), cB + kstep, voffB); PG8_STAGE(PG8_SA(1, 0), cA + kstep, voffA); PG8_STAGE(PG8_SB(1, 1), cB + hstep + kstep, voffB);
    PG8_WAIT_V(6); PG8_BAR;
    for (;;) {
        const bool has_next = S.next(ui + 1, nxt);
        const char* nA = has_next ? (const char*)g.A + (size_t)nxt.pm * tstep : cA; const char* nB = has_next ? (const char*)g.Bt + (size_t)nxt.pn * tstep : cB;
        for (int t = 0; t < nt; t += 2) {
            const bool last = (t == nt - 2);
            const char* a1 = cA + (size_t)(t + 1) * kstep;
            const char* a2 = last ? nA : cA + (size_t)(t + 2) * kstep; const char* b2 = last ? nB : cB + (size_t)(t + 2) * kstep;
            const char* a3 = a2 + kstep; const char* b3 = b2 + kstep;
            PG8_LDB(B0, 0, 0); PG8_LDB(B1, 0, 1); PG8_SCHED; PG8_LDA(At, 0, 0); PG8_STAGE(PG8_SA(1, 1), a1 + hstep, voffA);
            PG8_WAIT_V(8); PG8_WAIT_L(0); PG8_BAR; PG8_MMA(0, 0, At, B0); PG8_MMA(0, 1, At, B1); PG8_BAR; PG8_SCHED;
            PG8_LDA(At, 0, 1); PG8_STAGE(PG8_SB(0, 0), b2, voffB); PG8_STAGE(PG8_SB(0, 1), b2 + hstep, voffB); PG8_STAGE(PG8_SA(0, 0), a2, voffA);
            PG8_WAIT_V(8); PG8_WAIT_L(0); PG8_BAR; PG8_MMA(1, 0, At, B0); PG8_MMA(1, 1, At, B1); PG8_BAR; PG8_SCHED;
            PG8_LDB(B0, 1, 0); PG8_LDB(B1, 1, 1); PG8_SCHED; PG8_LDA(At, 1, 0); PG8_STAGE(PG8_SA(0, 1), a2 + hstep, voffA);
            PG8_WAIT_V(8); PG8_WAIT_L(0); PG8_BAR; PG8_MMA(0, 0, At, B0); PG8_MMA(0, 1, At, B1); PG8_BAR; PG8_SCHED;
            PG8_LDA(At, 1, 1); PG8_STAGE(PG8_SB(1, 0), b3, voffB); PG8_STAGE(PG8_SB(1, 1), b3 + hstep, voffB); PG8_STAGE(PG8_SA(1, 0), a3, voffA);
            PG8_WAIT_V(8); PG8_WAIT_L(0); PG8_BAR; PG8_MMA(1, 0, At, B0); PG8_MMA(1, 1, At, B1); PG8_BAR; PG8_SCHED;
        }
        if (wr == 0) PG8_BAR;
        E(acc, cur, wr, wc, fr, fq, xl);
        if (!has_next) break;
#pragma unroll
        for (int a = 0; a < 2; ++a)
#pragma unroll
            for (int b = 0; b < 2; ++b)
#pragma unroll
                for (int m = 0; m < 4; ++m)
#pragma unroll
                    for (int n = 0; n < 2; ++n) acc[a][b][m][n] = (f32x4){0.f, 0.f, 0.f, 0.f};
        cur = nxt; cA = nA; cB = nB; ++ui;
        if (wr == 1) PG8_BAR;
    }
    PG8_WAIT_V(0);
    PG8_BAR;
#undef PG8_SA
#undef PG8_SB
#undef PG8_STAGE
#undef PG8_LDA
#undef PG8_LDB
#undef PG8_MMA
#undef PG8_WAIT_V
#undef PG8_WAIT_L
#undef PG8_BAR
#undef PG8_SCHED
}
}

constexpr int MTOK = 32768, DM = 2048, SEQ = 4096, NB = 8, INW = 6144, FF = 5632, PLE = 256, AW = 1024, HW = 1024;
constexpr float EPS = 1e-6f;
constexpr size_t MiB = (size_t)1 << 20;
constexpr size_t WS_WIN = 0, WS_WOUT = 24 * MiB, WS_WGU = 32 * MiB, WS_WDOWN = 76 * MiB, WS_WGATE = 98 * MiB, WS_WPROJ = 106 * MiB;
constexpr size_t WS_HR = 107 * MiB;
constexpr size_t WS_SMALL = 124 * MiB;
constexpr size_t WS_RSTDX = WS_SMALL, WS_SSE = WS_SMALL + 128 * 1024, WS_SS1 = WS_SMALL + 256 * 1024, WS_SS2 = WS_SMALL + 384 * 1024, WS_BTAB = WS_SMALL + 512 * 1024, WS_LSE = WS_SMALL + MiB;
constexpr size_t WS_BAR = WS_SMALL + 640 * 1024;
constexpr size_t WS_OG = 128 * MiB, WS_ERAW = 128 * MiB, WS_XB = 256 * MiB, WS_H2B = 256 * MiB, WS_PB = 384 * MiB;
constexpr size_t WS_Q = 400 * MiB, WS_K = 464 * MiB, WS_V = 528 * MiB, WS_YT = 400 * MiB, WS_H1B = 464 * MiB;
constexpr size_t WS_HY = 592 * MiB, WS_Y = 592 * MiB, WS_ACT = 592 * MiB, WS_ZT = 784 * MiB, WS_X0T = 848 * MiB, WS_END = 944 * MiB;
constexpr int HRLEN = 8320, HROFF = 4160;
constexpr int LDS_BYTES = 155648;
constexpr int XL_OFF = 131072, BARST_OFF = LDS_BYTES - 16;
constexpr int NPH = 9;

struct Args { const float* in[27]; float* out; unsigned char* ws; int ph_lo, ph_hi; };

using pg8::Unit;
struct EpiIn {
    unsigned char* ws; const float* qg; const float* kg;
    __device__ __forceinline__ void operator()(const f32x4 (&acc)[2][2][4][2], const Unit& u, int wr, int wc, int fr, int fq, LAS float* P) const {
        const float* rstd = (const float*)(ws + WS_RSTDX);
        const int rowl0 = wr * 64 + fr, row0 = u.pm * 256 + rowl0;
        if (u.pn < 8) {
#pragma unroll
            for (int ai = 0; ai < 2; ++ai)
#pragma unroll
                for (int m = 0; m < 4; ++m) { const float rs = rstd[row0 + ai * 128 + m * 16];
#pragma unroll
                    for (int bj = 0; bj < 2; ++bj) { float s = (dot4(acc[ai][bj][m][0]) + dot4(acc[ai][bj][m][1])) * rs * rs;
                        s += __shfl_xor(s, 16); s += __shfl_xor(s, 32);
                        if (fq == 0) P[((rowl0 + ai * 128 + m * 16) * 2 + bj) * 4 + wc] = s; } }
            asm volatile("s_waitcnt lgkmcnt(0)" ::: "memory"); __builtin_amdgcn_s_barrier(); asm volatile("" ::: "memory");
            const bool isq = u.pn < 4; const float* gp = (isq ? qg : kg) + wc * 32 + fq * 8; const float sc = isq ? 0.08838834764831845f : 1.0f;
            const f32x4 g0 = *(const f32x4*)gp * sc, g1 = *(const f32x4*)(gp + 4) * sc;
            bf16_t* base = (bf16_t*)(ws + (isq ? WS_Q : WS_K)) + (u.pn & 3) * 256 + wc * 32 + fq * 8;
#pragma unroll
            for (int ai = 0; ai < 2; ++ai)
#pragma unroll
                for (int m = 0; m < 4; ++m) { const int rl = rowl0 + ai * 128 + m * 16; const float rs = rstd[row0 + ai * 128 + m * 16];
#pragma unroll
                    for (int bj = 0; bj < 2; ++bj) { const f32x4 pp = *(const LAS f32x4*)(P + (rl * 2 + bj) * 4);
                        const float tot = (pp[0] + pp[1]) + (pp[2] + pp[3]); const float r = rs * __builtin_amdgcn_rsqf(tot * (1.0f / 128.0f) + EPS);
                        const f32x4 v0 = acc[ai][bj][m][0] * r * g0, v1 = acc[ai][bj][m][1] * r * g1;
                        u32x4 w; w.x = cvt_pk_bf16(v0[0], v0[1]); w.y = cvt_pk_bf16(v0[2], v0[3]); w.z = cvt_pk_bf16(v1[0], v1[1]); w.w = cvt_pk_bf16(v1[2], v1[3]);
                        *(u32x4*)(base + (size_t)(u.pm * 256 + rl) * 1024 + bj * 128) = w; } }
        } else {
            const bool isv = u.pn < 12; const int ld = isv ? 1024 : 3072;
            bf16_t* base = (bf16_t*)(ws + (isv ? WS_V : WS_HY)) + (isv ? (u.pn - 8) : (u.pn - 12)) * 256 + wc * 32 + fq * 8;
#pragma unroll
            for (int ai = 0; ai < 2; ++ai)
#pragma unroll
                for (int m = 0; m < 4; ++m) { const int row = row0 + ai * 128 + m * 16; const float rs = rstd[row];
#pragma unroll
                    for (int bj = 0; bj < 2; ++bj) { const f32x4 v0 = acc[ai][bj][m][0] * rs, v1 = acc[ai][bj][m][1] * rs;
                        u32x4 w; w.x = cvt_pk_bf16(v0[0], v0[1]); w.y = cvt_pk_bf16(v0[2], v0[3]); w.z = cvt_pk_bf16(v1[0], v1[1]); w.w = cvt_pk_bf16(v1[2], v1[3]);
                        *(u32x4*)(base + (size_t)row * ld + bj * 128) = w; } }
        }
    }
};
struct EpiOut {
    const float* base; bf16_t* ob; float* ss;
    __device__ __forceinline__ void operator()(const f32x4 (&acc)[2][2][4][2], const Unit& u, int wr, int wc, int fr, int fq, LAS float*) const {
        const int row0 = u.pm * 256 + wr * 64 + fr, col0 = u.pn * 256 + wc * 32 + fq * 8;
#pragma unroll
        for (int ai = 0; ai < 2; ++ai)
#pragma unroll
            for (int m = 0; m < 4; ++m) { const int row = row0 + ai * 128 + m * 16; float s = 0.f;
#pragma unroll
                for (int bj = 0; bj < 2; ++bj) { const size_t off = (size_t)row * DM + col0 + bj * 128;
                    const f32x4 h0 = *(const f32x4*)(base + off) + acc[ai][bj][m][0], h1 = *(const f32x4*)(base + off + 4) + acc[ai][bj][m][1];
                    u32x4 w; w.x = cvt_pk_bf16(h0[0], h0[1]); w.y = cvt_pk_bf16(h0[2], h0[3]); w.z = cvt_pk_bf16(h1[0], h1[1]); w.w = cvt_pk_bf16(h1[2], h1[3]);
                    *(u32x4*)(ob + off) = w; s += dot4(h0) + dot4(h1); }
                s += __shfl_xor(s, 16); s += __shfl_xor(s, 32);
                if (fq == 0) atomicAdd(ss + row, s);
                asm volatile("" ::: "memory"); }
    }
};
struct EpiDown {
    const bf16_t* hb; bf16_t* ob; float* ss;
    __device__ __forceinline__ void operator()(const f32x4 (&acc)[2][2][4][2], const Unit& u, int wr, int wc, int fr, int fq, LAS float*) const {
        const int row0 = u.pm * 256 + wr * 64 + fr, col0 = u.pn * 256 + wc * 32 + fq * 8;
#pragma unroll
        for (int ai = 0; ai < 2; ++ai)
#pragma unroll
            for (int m = 0; m < 4; ++m) { const int row = row0 + ai * 128 + m * 16; float s = 0.f;
#pragma unroll
                for (int bj = 0; bj < 2; ++bj) { const size_t off = (size_t)row * DM + col0 + bj * 128; const u32x4 hw = *(const u32x4*)(hb + off);
                    const f32x4 h0 = (f32x4){bf_lo(hw.x), bf_hi(hw.x), bf_lo(hw.y), bf_hi(hw.y)} + acc[ai][bj][m][0], h1 = (f32x4){bf_lo(hw.z), bf_hi(hw.z), bf_lo(hw.w), bf_hi(hw.w)} + acc[ai][bj][m][1];
                    u32x4 w; w.x = cvt_pk_bf16(h0[0], h0[1]); w.y = cvt_pk_bf16(h0[2], h0[3]); w.z = cvt_pk_bf16(h1[0], h1[1]); w.w = cvt_pk_bf16(h1[2], h1[3]);
                    *(u32x4*)(ob + off) = w; s += dot4(h0) + dot4(h1); }
                s += __shfl_xor(s, 16); s += __shfl_xor(s, 32);
                if (fq == 0) atomicAdd(ss + row, s);
                asm volatile("" ::: "memory"); }
    }
};
struct EpiProj {
    bf16_t* ob; float* ss;
    __device__ __forceinline__ void operator()(const f32x4 (&acc)[2][2][4][2], const Unit& u, int wr, int wc, int fr, int fq, LAS float*) const {
        const int row0 = u.pm * 256 + wr * 64 + fr, col0 = u.pn * 256 + wc * 32 + fq * 8;
#pragma unroll
        for (int ai = 0; ai < 2; ++ai)
#pragma unroll
            for (int m = 0; m < 4; ++m) { const int row = row0 + ai * 128 + m * 16; float s = 0.f;
#pragma unroll
                for (int bj = 0; bj < 2; ++bj) { const size_t off = (size_t)row * DM + col0 + bj * 128; const f32x4 h0 = acc[ai][bj][m][0], h1 = acc[ai][bj][m][1];
                    u32x4 w; w.x = cvt_pk_bf16(h0[0], h0[1]); w.y = cvt_pk_bf16(h0[2], h0[3]); w.z = cvt_pk_bf16(h1[0], h1[1]); w.w = cvt_pk_bf16(h1[2], h1[3]);
                    *(u32x4*)(ob + off) = w; s += dot4(h0) + dot4(h1); }
                s += __shfl_xor(s, 16); s += __shfl_xor(s, 32);
                if (fq == 0) atomicAdd(ss + row, s); }
    }
};
struct EpiGU {
    bf16_t* act; const float* ss;
    __device__ __forceinline__ void operator()(const f32x4 (&acc)[2][2][4][2], const Unit& u, int wr, int wc, int fr, int fq, LAS float*) const {
        const int row0 = u.pm * 256 + wr * 64 + fr, col0 = u.pn * 128 + wc * 32 + fq * 8;
#pragma unroll
        for (int ai = 0; ai < 2; ++ai)
#pragma unroll
            for (int m = 0; m < 4; ++m) { const int row = row0 + ai * 128 + m * 16; const float rs = __builtin_amdgcn_rsqf(ss[row] * (1.0f / DM) + EPS);
                float o[8];
#pragma unroll
                for (int n = 0; n < 2; ++n)
#pragma unroll
                    for (int j = 0; j < 4; ++j) { const float a = acc[ai][0][m][n][j] * rs, gg = acc[ai][1][m][n][j] * rs;
                        o[n * 4 + j] = a * __builtin_amdgcn_rcpf(1.0f + __expf(-a)) * gg; }
                u32x4 w; w.x = cvt_pk_bf16(o[0], o[1]); w.y = cvt_pk_bf16(o[2], o[3]); w.z = cvt_pk_bf16(o[4], o[5]); w.w = cvt_pk_bf16(o[6], o[7]);
                *(u32x4*)(act + (size_t)row * FF + col0) = w; }
    }
};
struct EpiGate {
    float* out; const bf16_t* hb; const bf16_t* eraw; const float* ss2; const float* ssE; const float* post;
    __device__ __forceinline__ void operator()(const f32x4 (&acc)[2][2][4][2], const Unit& u, int wr, int wc, int fr, int fq, LAS float*) const {
        const int row0 = u.pm * 256 + wr * 64 + fr, col0 = u.pn * 256 + wc * 32 + fq * 8;
#pragma unroll
        for (int ai = 0; ai < 2; ++ai)
#pragma unroll
            for (int m = 0; m < 4; ++m) { const int row = row0 + ai * 128 + m * 16;
                const float rs2 = __builtin_amdgcn_rsqf(ss2[row] * (1.0f / DM) + EPS), rsE = __builtin_amdgcn_rsqf(ssE[row] * (1.0f / DM) + EPS);
#pragma unroll
                for (int bj = 0; bj < 2; ++bj) { const size_t off = (size_t)row * DM + col0 + bj * 128;
                    const u32x4 ew = *(const u32x4*)(eraw + off); const f32x4 p0 = *(const f32x4*)(post + col0 + bj * 128), p1 = *(const f32x4*)(post + col0 + bj * 128 + 4);
                    const f32x4 e0 = (f32x4){bf_lo(ew.x), bf_hi(ew.x), bf_lo(ew.y), bf_hi(ew.y)} * rsE * p0, e1 = (f32x4){bf_lo(ew.z), bf_hi(ew.z), bf_lo(ew.w), bf_hi(ew.w)} * rsE * p1;
                    const u32x4 hw = *(const u32x4*)(hb + off);
                    f32x4 h0 = (f32x4){bf_lo(hw.x), bf_hi(hw.x), bf_lo(hw.y), bf_hi(hw.y)}, h1 = (f32x4){bf_lo(hw.z), bf_hi(hw.z), bf_lo(hw.w), bf_hi(hw.w)};
#pragma unroll
                    for (int j = 0; j < 4; ++j) { h0[j] += __builtin_amdgcn_rcpf(1.0f + __expf(-acc[ai][bj][m][0][j] * rs2)) * e0[j]; h1[j] += __builtin_amdgcn_rcpf(1.0f + __expf(-acc[ai][bj][m][1][j] * rs2)) * e1[j]; }
                    *(f32x4*)(out + off) = h0; *(f32x4*)(out + off + 4) = h1; }
                asm volatile("" ::: "memory"); }
    }
};

__device__ __forceinline__ void p0_transpose_blk(const float* W, const float* gain, int K, int N, bf16_t* WT, int gu, LAS unsigned char* T, int item) {
    const int tid = threadIdx.x, lane = tid & 63, w = __builtin_amdgcn_readfirstlane(tid >> 6);
    const int nblk = N / 256, kb = item / nblk, nb = item % nblk, k0 = 64 * kb, n0 = 256 * nb;
    f32x4 v[8];
#pragma unroll
    for (int i = 0; i < 8; ++i) v[i] = *(const f32x4*)(W + (size_t)(k0 + 8 * w + i) * N + n0 + 4 * lane);
    if (gain) {
#pragma unroll
        for (int i = 0; i < 8; ++i) v[i] *= gain[k0 + 8 * w + i]; }
#pragma unroll
    for (int j = 0; j < 4; ++j) { u32x4 o; o.x = cvt_pk_bf16(v[0][j], v[1][j]); o.y = cvt_pk_bf16(v[2][j], v[3][j]); o.z = cvt_pk_bf16(v[4][j], v[5][j]); o.w = cvt_pk_bf16(v[6][j], v[7][j]);
        *(LAS u32x4*)(T + (4 * lane + j) * 128 + ((w ^ (lane & 7)) * 16)) = o; }
    __syncthreads();
    int ndb = n0;
    if (gu) { const int s = n0 >= FF ? 1 : 0, j = n0 - s * FF; ndb = 256 * (j >> 7) + 128 * s; }
#pragma unroll
    for (int i = 0; i < 4; ++i) { const int id = tid + 512 * i, n = id >> 3, c = id & 7;
        const u32x4 o = *(const LAS u32x4*)(T + n * 128 + ((c ^ ((n >> 2) & 7)) * 16));
        const int nd = gu ? (ndb + 256 * (n >> 7) + (n & 127)) : (n0 + n);
        *(u32x4*)(WT + (size_t)nd * K + k0 + 8 * c) = o; }
    __syncthreads();
}
__device__ __forceinline__ float wave_sum(float v) {
#pragma unroll
    for (int o = 1; o < 64; o <<= 1) v += __shfl_xor(v, o);
    return v;
}
__device__ __forceinline__ int t5_bucket(int rel) {
    const int n = rel < 0 ? -rel : rel;
    int large = 8 + (int)(logf((float)(n < 1 ? 1 : n) / 8.0f) / logf(128.0f) * 8.0f);
    if (large > 15) large = 15;
    return (rel > 0 ? 16 : 0) + (n < 8 ? n : large);
}
__device__ __forceinline__ void p0_prologue(const Args& A, LAS unsigned char* lds) {
    const int tid = threadIdx.x, lane = tid & 63, wave = tid >> 6, G = gridDim.x, gw = blockIdx.x * 8 + wave, NGW = G * 8;
    unsigned char* ws = A.ws;
    {
        constexpr int I_IN = 32 * 24, I_OUT = 32 * 8, I_GU = 32 * 44, I_DN = 88 * 8, I_GT = 32 * 8, I_PJ = 4 * 8;
        constexpr int NIT = I_IN + I_OUT + I_GU + I_DN + I_GT + I_PJ;
        for (int it = blockIdx.x; it < NIT; it += G) {
            int r = it;
            if (r < I_IN) { p0_transpose_blk(A.in[4], A.in[3], DM, INW, (bf16_t*)(ws + WS_WIN), 0, lds, r); continue; } r -= I_IN;
            if (r < I_OUT) { p0_transpose_blk(A.in[19], nullptr, DM, DM, (bf16_t*)(ws + WS_WOUT), 0, lds, r); continue; } r -= I_OUT;
            if (r < I_GU) { p0_transpose_blk(A.in[21], A.in[20], DM, 2 * FF, (bf16_t*)(ws + WS_WGU), 1, lds, r); continue; } r -= I_GU;
            if (r < I_DN) { p0_transpose_blk(A.in[22], nullptr, FF, DM, (bf16_t*)(ws + WS_WDOWN), 0, lds, r); continue; } r -= I_DN;
            if (r < I_GT) { p0_transpose_blk(A.in[24], A.in[23], DM, DM, (bf16_t*)(ws + WS_WGATE), 0, lds, r); continue; } r -= I_GT;
            p0_transpose_blk(A.in[25], nullptr, PLE, DM, (bf16_t*)(ws + WS_WPROJ), 0, lds, r);
        }
    }
    {
        const float* x = A.in[0]; bf16_t* xb = (bf16_t*)(ws + WS_XB); float* rstd = (float*)(ws + WS_RSTDX);
        for (int m = gw; m < MTOK; m += NGW) {
            const f32x4* xr = (const f32x4*)(x + (size_t)m * DM) + lane; f32x4 v[8]; float s = 0.f;
#pragma unroll
            for (int j = 0; j < 8; ++j) { v[j] = xr[64 * j]; s += dot4(v[j]); }
            s = wave_sum(s);
            if (lane == 0) rstd[m] = 1.0f / sqrtf(s * (1.0f / DM) + EPS);
            u32x2* o = (u32x2*)(xb + (size_t)m * DM) + lane;
#pragma unroll
            for (int j = 0; j < 8; ++j) { u32x2 w; w.x = cvt_pk_bf16(v[j][0], v[j][1]); w.y = cvt_pk_bf16(v[j][2], v[j][3]); o[64 * j] = w; }
        }
    }
    {
        const size_t gt = (size_t)blockIdx.x * 512 + tid, NT = (size_t)G * 512;
        const f32x4* p4 = (const f32x4*)A.in[1]; u32x2* pb = (u32x2*)(ws + WS_PB);
        _Pragma("unroll 4") for (size_t i = gt; i < (size_t)MTOK * PLE / 4; i += NT) { const f32x4 v = p4[i]; u32x2 w; w.x = cvt_pk_bf16(v[0], v[1]); w.y = cvt_pk_bf16(v[2], v[3]); pb[i] = w; }
        float* z = (float*)(ws + WS_SSE);
        for (size_t i = gt; i < 3 * (size_t)MTOK; i += NT) z[i] = 0.f;
        if (blockIdx.x == 0) { float* bt = (float*)(ws + WS_BTAB); const float* rb = A.in[2];
            for (int i = tid; i < 3 * 8 * 129; i += 512) { const int g = i / (8 * 129), h = (i / 129) % 8, rel = i % 129 - 64; const int d = g == 0 ? 1 : (g == 1 ? 4 : 16);
                bt[i] = rb[t5_bucket(rel * d) * 8 + h]; } }
    }
    {
        LAS float* zf = (LAS float*)lds;
        LAS float* hA = zf + 16 * 33;
        LAS float* hB = hA + 16 * 64;
        const float* w1 = A.in[9]; const float* b1 = A.in[10]; const float* wi = A.in[11]; const float* bi = A.in[12]; const float* wo = A.in[13];
        const float* fq = A.in[14]; const float* dec = A.in[15]; const float* hb = A.in[16];
        bf16_t* hr = (bf16_t*)(ws + WS_HR);
        __syncthreads();
        for (int z = blockIdx.x; z < 263; z += G) { const int q = z < 132 ? z : z + 257;
            for (int c = tid; c < HW; c += 512) { u32x4* d = (u32x4*)(hr + (size_t)c * HRLEN + 16 * q); d[0] = (u32x4){0u, 0u, 0u, 0u}; d[1] = (u32x4){0u, 0u, 0u, 0u}; } }
        for (int r = blockIdx.x; r < 256; r += G) {
            const bool edge = (r == 255);
#define FPOS(sl) (edge ? ((sl) < 15 ? 4095 - (sl) : 0) : (HROFF + 2048 - (16 * (133 + r) + (sl))))
            for (int t = tid; t < 16 * 33; t += 512) { const int pi = t / 33, f = t % 33; const float pos = (float)FPOS(pi); float v;
                if (f == 0) v = pos / 4095.0f;
                else { const int k = (f - 1) & 15; const float fr = 1e-4f + (float)k * ((15.0f - 1e-4f) / 15.0f); const float ang = ((float)(2.0 * 3.14159265358979323846 / 4096.0) * pos) * fr;
                    v = (f <= 16) ? cosf(ang) : -sinf(ang); }
                zf[t] = v; }
            __syncthreads();
#pragma unroll
            for (int h2 = 0; h2 < 2; ++h2) { const int e = tid + 512 * h2, pi = e >> 6, uu = e & 63; float sacc = b1[uu];
                _Pragma("unroll 11") for (int f = 0; f < 33; ++f) sacc += zf[pi * 33 + f] * w1[f * 64 + uu];
                hA[pi * 64 + uu] = sinf(fq[uu] * sacc); }
            __syncthreads();
#pragma unroll
            for (int h2 = 0; h2 < 2; ++h2) { const int e = tid + 512 * h2, pi = e >> 6, uu = e & 63; float sacc = bi[uu];
                _Pragma("unroll 32") for (int k = 0; k < 64; ++k) sacc += hA[pi * 64 + k] * wi[k * 64 + uu];
                hB[pi * 64 + uu] = sinf(fq[uu] * sacc); }
            __syncthreads();
#pragma unroll
            for (int h2 = 0; h2 < 2; ++h2) { const int e = tid + 512 * h2, pi = e >> 6, uu = e & 63; float sacc = bi[64 + uu];
                _Pragma("unroll 32") for (int k = 0; k < 64; ++k) sacc += hB[pi * 64 + k] * wi[4096 + k * 64 + uu];
                hA[pi * 64 + uu] = sinf(fq[uu] * sacc); }
            __syncthreads();
#pragma unroll 1
            for (int cc = 0; cc < 2; ++cc) { const int c = tid + 512 * cc; float a[16];
#pragma unroll
                for (int pi = 0; pi < 16; ++pi) a[pi] = 0.f;
                _Pragma("unroll 16") for (int k = 0; k < 64; ++k) { const float w = wo[k * HW + c];
#pragma unroll
                    for (int pi = 0; pi < 16; ++pi) a[pi] += hA[pi * 64 + k] * w; }
                const float ad = fabsf(dec[c]);
#pragma unroll
                for (int pi = 0; pi < 16; ++pi) { const int p = FPOS(pi); const int ao = p >= 2048 ? p - 2048 : 2048 - p; const float offs = (float)ao * (1.0f / 2048.0f);
                    float v = a[pi] * expf(-offs * ad); if (p == 2048) v += hb[c]; a[pi] = v; }
                bf16_t* row = hr + (size_t)c * HRLEN;
                if (!edge) { u32x4* d = (u32x4*)(row + 16 * (133 + r));
                    d[0] = (u32x4){cvt_pk_bf16(a[0], a[1]), cvt_pk_bf16(a[2], a[3]), cvt_pk_bf16(a[4], a[5]), cvt_pk_bf16(a[6], a[7])};
                    d[1] = (u32x4){cvt_pk_bf16(a[8], a[9]), cvt_pk_bf16(a[10], a[11]), cvt_pk_bf16(a[12], a[13]), cvt_pk_bf16(a[14], a[15])}; }
                else { u32x4* dA = (u32x4*)(row + 2112); u32x4* dB = (u32x4*)(row + 6208);
                    dA[0] = (u32x4){cvt_pk_bf16(0.f, a[0]), cvt_pk_bf16(a[1], a[2]), cvt_pk_bf16(a[3], a[4]), cvt_pk_bf16(a[5], a[6])};
                    dA[1] = (u32x4){cvt_pk_bf16(a[7], a[8]), cvt_pk_bf16(a[9], a[10]), cvt_pk_bf16(a[11], a[12]), cvt_pk_bf16(a[13], a[14])};
                    dB[0] = (u32x4){cvt_pk_bf16(a[15], 0.f), 0u, 0u, 0u}; dB[1] = (u32x4){0u, 0u, 0u, 0u}; } }
            __syncthreads();
#undef FPOS
        }
    }
}

constexpr int KPITCH = 272, VPITCH = 288, AT_VS = 256 * KPITCH, AT_BT = AT_VS + 272 * VPITCH;
constexpr int ATT_ITEMS = 6144;
__device__ __forceinline__ void att_decode(int item, int& g, int& b, int& h, int& r, int& n0, int& dsh) {
    g = item >> 11; const int rem = item & 2047, bh = rem >> 5, sub = rem & 31; b = bh >> 3; h = bh & 7;
    dsh = g == 0 ? 0 : (g == 1 ? 2 : 4); const int psh = g == 0 ? 5 : (g == 1 ? 3 : 1);
    r = sub >> psh; n0 = 2 * (sub & ((1 << psh) - 1));
}
__device__ __forceinline__ void att_issue(const unsigned char* ws, int item, int tid, int wave, int lane, u32x4 (&pre)[16], bf16x8 (&qpre)[4], float& bpre, unsigned& vmask) {
    int g, b, h, r, n0, dsh; att_decode(item, g, b, h, r, n0, dsh);
    const int Ls = SEQ >> dsh, tokbase = b * SEQ;
    const bf16_t* Qp = (const bf16_t*)(ws + WS_Q); const bf16_t* Kp = (const bf16_t*)(ws + WS_K); const bf16_t* Vp = (const bf16_t*)(ws + WS_V);
    unsigned vm = 0u;
#pragma unroll
    for (int i = 0; i < 16; ++i) { const int c2 = (tid + 512 * i) & 4095, ki = c2 >> 4, cc = c2 & 15, idx = 64 * (n0 - 1) + ki;
        const bool ok = idx >= 0 && idx < Ls; const int pos = ((ok ? idx : 0) << dsh) + r;
        pre[i] = *(const u32x4*)((i < 8 ? Kp : Vp) + (size_t)(tokbase + pos) * AW + h * 128 + cc * 8);
        vm |= (ok ? 1u : 0u) << i; }
    vmask = vm;
    { const int qb = wave >> 2, t = wave & 3, idxq = 64 * (n0 + qb) + 16 * t + (lane & 15); const int tokq = tokbase + (idxq << dsh) + r;
        const bf16_t* qp = Qp + (size_t)tokq * AW + h * 128 + 8 * (lane >> 4);
#pragma unroll
        for (int kk = 0; kk < 4; ++kk) qpre[kk] = *(const bf16x8*)(qp + 32 * kk); }
    { const int bi = tid - 15; bpre = ((const float*)(ws + WS_BTAB))[(g * 8 + h) * 129 + (bi < 0 ? 0 : (bi > 128 ? 128 : bi))]; }
}
__device__ __forceinline__ void att_body(unsigned char* ws, LAS unsigned char* ks, LAS unsigned char* vs, LAS float* btab, int item, int nxt, int tid, int wave, int lane,
                                         u32x4 (&pre)[16], bf16x8 (&qpre)[4], float& bpre, unsigned& vmask) {
#pragma unroll
        for (int i = 0; i < 16; ++i) { const int c2 = (tid + 512 * i) & 4095, ki = c2 >> 4, cc = c2 & 15;
            u32x4 v = pre[i]; if (!((vmask >> i) & 1u)) v = (u32x4){0u, 0u, 0u, 0u};
            if (i < 8) *(LAS u32x4*)(ks + ki * KPITCH + cc * 16) = v; else *(LAS u32x4*)(vs + ki * VPITCH + cc * 16) = v; }
        if (tid < 160) btab[tid] = (tid >= 15 && tid <= 143) ? bpre : -1.0e30f;
        bf16x8 qf[4];
#pragma unroll
        for (int kk = 0; kk < 4; ++kk) qf[kk] = qpre[kk];
        asm volatile("s_waitcnt lgkmcnt(0)" ::: "memory"); __builtin_amdgcn_s_barrier(); asm volatile("" ::: "memory");
        att_issue(ws, nxt, tid, wave, lane, pre, qpre, bpre, vmask);
        {
            int g, b, h, r, n0, dsh; att_decode(item, g, b, h, r, n0, dsh);
            const int Ls = SEQ >> dsh, tokbase = b * SEQ;
            const int qb = wave >> 2, t = wave & 3, n = n0 + qb, l15 = lane & 15, rg = lane >> 4;
            const int tokq = tokbase + ((64 * n + 16 * t + l15) << dsh) + r;
            f32x4 S[9];
            const LAS unsigned char* kb = ks + (64 * qb + 16 * t + l15) * KPITCH + 16 * rg;
            bf16x8 kfa[9], kfb[9];
#pragma unroll
            for (int kt = 0; kt < 9; ++kt) { S[kt] = (f32x4){0.f, 0.f, 0.f, 0.f}; kfa[kt] = *(const LAS bf16x8*)(kb + (16 * kt) * KPITCH); }
#pragma unroll
            for (int kk = 0; kk < 4; ++kk) {
                if (kk < 3) {
#pragma unroll
                    for (int kt = 0; kt < 9; ++kt) { if (kk & 1) kfa[kt] = *(const LAS bf16x8*)(kb + (16 * kt) * KPITCH + 64 * (kk + 1)); else kfb[kt] = *(const LAS bf16x8*)(kb + (16 * kt) * KPITCH + 64 * (kk + 1)); } }
#pragma unroll
                for (int kt = 0; kt < 9; ++kt) S[kt] = __builtin_amdgcn_mfma_f32_16x16x32_bf16((kk & 1) ? kfb[kt] : kfa[kt], qf[kk], S[kt], 0, 0, 0);
            }
            float mx = -3.0e38f;
            const int idxk0 = 64 * (n - 1) + 16 * t + 4 * rg;
            const LAS float* tb = btab + (4 * rg - l15 + 15);
#pragma unroll
            for (int kt = 0; kt < 9; ++kt)
#pragma unroll
                for (int j = 0; j < 4; ++j) { const int idxk = idxk0 + 16 * kt + j;
                    const float pen = (idxk >= 0 && idxk < Ls) ? 0.f : -1.0e30f;
                    const float sv = fmaxf((S[kt][j] + tb[16 * kt + j]) + pen, -1.0e30f);
                    S[kt][j] = sv; mx = fmaxf(mx, sv); }
            mx = fmaxf(mx, __shfl_xor(mx, 16)); mx = fmaxf(mx, __shfl_xor(mx, 32));
            float lsum = 0.f; bf16x8 pf[5];
#pragma unroll
            for (int ksx = 0; ksx < 5; ++ksx) { float e[8];
#pragma unroll
                for (int j = 0; j < 4; ++j) { e[j] = __expf(S[2 * ksx][j] - mx); e[4 + j] = (2 * ksx + 1 < 9) ? __expf(S[(2 * ksx + 1 < 9) ? 2 * ksx + 1 : 8][j] - mx) : 0.f; }
#pragma unroll
                for (int j = 0; j < 8; ++j) lsum += e[j];
                u32x4 w; w.x = cvt_pk_bf16(e[0], e[1]); w.y = cvt_pk_bf16(e[2], e[3]); w.z = cvt_pk_bf16(e[4], e[5]); w.w = cvt_pk_bf16(e[6], e[7]);
                pf[ksx] = __builtin_bit_cast(bf16x8, w); }
            lsum += __shfl_xor(lsum, 16); lsum += __shfl_xor(lsum, 32);
            f32x4 O[8];
#pragma unroll
            for (int ct = 0; ct < 8; ++ct) O[ct] = (f32x4){0.f, 0.f, 0.f, 0.f};
            const LAS unsigned char* vb = vs + (64 * qb + 16 * t + 4 * rg + (l15 >> 2)) * VPITCH + 64 * (lane & 3);
#pragma unroll
            for (int ksx = 0; ksx < 5; ++ksx)
#pragma unroll
                for (int ct = 0; ct < 8; ++ct) {
                    const s16x4 lo = __builtin_amdgcn_ds_read_tr16_b64_v4i16((LAS s16x4*)(vb + (32 * ksx) * VPITCH + 8 * ct));
                    const s16x4 hi = __builtin_amdgcn_ds_read_tr16_b64_v4i16((LAS s16x4*)(vb + (32 * ksx + 16) * VPITCH + 8 * ct));
                    const bf16x8 vf = __builtin_shufflevector(lo, hi, 0, 1, 2, 3, 4, 5, 6, 7);
                    O[ct] = __builtin_amdgcn_mfma_f32_16x16x32_bf16(vf, pf[ksx], O[ct], 0, 0, 0); }
            bf16_t* op = (bf16_t*)(ws + WS_OG) + ((size_t)g * MTOK + tokq) * AW + h * 128 + 32 * rg; const float inv = 1.0f / lsum;
#pragma unroll
            for (int c2 = 0; c2 < 4; ++c2) { const f32x4 o0 = O[2 * c2] * inv, o1 = O[2 * c2 + 1] * inv;
                u32x4 w; w.x = cvt_pk_bf16(o0[0], o0[1]); w.y = cvt_pk_bf16(o0[2], o0[3]); w.z = cvt_pk_bf16(o1[0], o1[1]); w.w = cvt_pk_bf16(o1[2], o1[3]); *(u32x4*)(op + 8 * c2) = w; }
            ((float*)(ws + WS_LSE))[((size_t)g * MTOK + tokq) * 8 + h] = mx + __logf(lsum);
        }
        asm volatile("s_waitcnt lgkmcnt(0)" ::: "memory"); __builtin_amdgcn_s_barrier(); asm volatile("" ::: "memory");
}
__device__ __forceinline__ void attn_phase(const Args& A, LAS unsigned char* lds) {
    const int tid = threadIdx.x, lane = tid & 63, wave = __builtin_amdgcn_readfirstlane(tid >> 6), G = gridDim.x;
    unsigned char* ws = A.ws;
    LAS unsigned char* ks = lds; LAS unsigned char* vs = lds + AT_VS; LAS float* btab = (LAS float*)(lds + AT_BT);
    if (tid < 288) *(LAS u32x4*)(vs + 256 * VPITCH + tid * 16) = (u32x4){0u, 0u, 0u, 0u};
    u32x4 pre[16]; bf16x8 qpre[4]; float bpre; unsigned vmask;
    const bool xmap = (G == 256);
    const int per = xmap ? 24 : (ATT_ITEMS + G - 1) / G;
    const int ibase = blockIdx.x * per, nit = xmap ? 24 : ((ibase + per) < ATT_ITEMS ? per : (ATT_ITEMS - ibase > 0 ? ATT_ITEMS - ibase : 0));
#define ATT_MAP(i) (xmap ? (((((3 * (int)(blockIdx.x >> 3) + (i) % 3) >> 5) << 11) | (((int)(blockIdx.x & 7) + 8 * ((i) / 3)) << 5) | ((3 * (int)(blockIdx.x >> 3) + (i) % 3) & 31))) : (ibase + (i)))
    if (nit > 0) {
        int item = ATT_MAP(0);
        att_issue(ws, item, tid, wave, lane, pre, qpre, bpre, vmask);
        { const int nxt = ATT_MAP(1 < nit ? 1 : 0); att_body(ws, ks, vs, btab, item, nxt, tid, wave, lane, pre, qpre, bpre, vmask); item = nxt; }
        for (int ii = 1; ii < nit; ++ii) { const int nxt = ATT_MAP(ii + 1 < nit ? ii + 1 : ii); att_body(ws, ks, vs, btab, item, nxt, tid, wave, lane, pre, qpre, bpre, vmask); item = nxt; }
    }
#undef ATT_MAP
    __syncthreads();
}

__device__ __forceinline__ float bf_el(u32x2 r, int ch) { return ch == 0 ? bf_lo(r.x) : (ch == 1 ? bf_hi(r.x) : (ch == 2 ? bf_lo(r.y) : bf_hi(r.y))); }
__device__ __forceinline__ void sconv_phase(const Args& A) {
    const int tid = threadIdx.x, lane = tid & 63, wave = tid >> 6, gw = blockIdx.x * 8 + wave, NGW = gridDim.x * 8; unsigned char* ws = A.ws;
    const bf16_t* HY = (const bf16_t*)(ws + WS_HY); const float* cw = A.in[7]; const float* cb = A.in[8];
    bf16_t* zt = (bf16_t*)(ws + WS_ZT); bf16_t* x0t = (bf16_t*)(ws + WS_X0T);
    const int b = lane >> 3, cgp = lane & 7;
    const bool xmap = (gridDim.x == 256);
    const int wid = (int)(blockIdx.x >> 3) * 8 + wave;
    for (int it = 0; it < (xmap ? 8 : (32 * 512 + NGW - 1) / NGW); ++it) {
        const int id = xmap ? ((8 * ((int)(blockIdx.x & 7) + 8 * it) + (wid >> 5)) * 32 + (wid & 31)) : (gw + NGW * it);
        if (id >= 32 * 512) break;
        const int ct = id & 31, q = id >> 5, c0 = 32 * ct + 4 * cgp, j0 = 8 * q;
        f32x4 w[3][3], bs[3];
#pragma unroll
        for (int s = 0; s < 3; ++s) { bs[s] = *(const f32x4*)(cb + s * 1024 + c0);
#pragma unroll
            for (int t = 0; t < 3; ++t) w[s][t] = *(const f32x4*)(cw + t * 3072 + s * 1024 + c0); }
        u32x2 rows[10][3];
#pragma unroll
        for (int rr = 0; rr < 10; ++rr) { const int js = j0 - 1 + rr; const bool ok = js >= 0 && js < SEQ; const bf16_t* rp = HY + (size_t)(b * SEQ + (ok ? js : 0)) * 3072 + c0;
#pragma unroll
            for (int s = 0; s < 3; ++s) { u32x2 v = *(const u32x2*)(rp + s * 1024); if (!ok) v = (u32x2){0u, 0u}; rows[rr][s] = v; } }
        unsigned ox[4][4], oz[4][4]; float px[4], pz[4];
#pragma unroll
        for (int jj = 0; jj < 8; ++jj) {
#pragma unroll
            for (int ch = 0; ch < 4; ++ch) { float v[3];
#pragma unroll
                for (int s = 0; s < 3; ++s) v[s] = bs[s][ch] + w[s][0][ch] * bf_el(rows[jj][s], ch) + w[s][1][ch] * bf_el(rows[jj + 1][s], ch) + w[s][2][ch] * bf_el(rows[jj + 2][s], ch);
                const float x0 = v[0], z = v[2] * v[1];
                if (jj & 1) { ox[ch][jj >> 1] = cvt_pk_bf16(px[ch], x0); oz[ch][jj >> 1] = cvt_pk_bf16(pz[ch], z); } else { px[ch] = x0; pz[ch] = z; } } }
#pragma unroll
        for (int ch = 0; ch < 4; ++ch) { const size_t dst = ((size_t)(c0 + ch) * 512 + q) * 64 + b * 8;
            *(u32x4*)(x0t + dst) = (u32x4){ox[ch][0], ox[ch][1], ox[ch][2], ox[ch][3]}; *(u32x4*)(zt + dst) = (u32x4){oz[ch][0], oz[ch][1], oz[ch][2], oz[ch][3]}; }
    }
}

__device__ __forceinline__ void lconv_item(const Args& A, LAS unsigned char* lds, int c) {
    const int tid = threadIdx.x, lane = tid & 63, wave = __builtin_amdgcn_readfirstlane(tid >> 6); unsigned char* ws = A.ws;
    LAS unsigned char* zs = lds; LAS unsigned char* hA = lds + 70144; LAS unsigned char* hB = hA + 16640;
    { const u32x4* zsrc = (const u32x4*)((const bf16_t*)(ws + WS_ZT) + (size_t)c * 32768);
        for (int ch = tid; ch < 4096; ch += 512) *(LAS u32x4*)(zs + 256 + ch * 16) = zsrc[ch];
        if (tid < 16) *(LAS u32x4*)(zs + tid * 16) = (u32x4){0u, 0u, 0u, 0u};
        if (tid >= 64 && tid < 336) *(LAS u32x4*)(zs + 65792 + (tid - 64) * 16) = (u32x4){0u, 0u, 0u, 0u};
        const u32x4* hsrc = (const u32x4*)((const bf16_t*)(ws + WS_HR) + (size_t)c * HRLEN);
        for (int ch = tid; ch < 1040; ch += 512) *(LAS u32x4*)(hA + ch * 16) = hsrc[ch]; }
    __syncthreads();
    for (int k = tid; k < 4160; k += 512) { const unsigned lo = ((const LAS unsigned*)hA)[k], hi = (k + 1 < 4160) ? ((const LAS unsigned*)hA)[k + 1] : 0u; ((LAS unsigned*)hB)[k] = (lo >> 16) | (hi << 16); }
    __syncthreads();
    {
        const int m = lane & 15, gq = lane >> 4;
        const LAS unsigned char* tbase = ((m & 1) ? (hB - 2) : hA) + 2 * (4144 + 8 * gq - m);
        const int bb = m & 7, sh = m >> 3;
        const LAS unsigned char* zbase = zs + ((2 * sh + gq) * 8 + bb) * 16;
        const bf16_t* x0t = (const bf16_t*)(ws + WS_X0T) + (size_t)c * 32768; bf16_t* yt = (bf16_t*)(ws + WS_YT) + (size_t)c * 32768;
#pragma unroll 1
        for (int ib = 0; ib < 2; ++ib) {
            const int It0 = 16 * wave + 8 * ib;
            const int jlo = (It0 - 64) > 0 ? (It0 - 64) : 0, jhi = (It0 + 71) < 128 ? (It0 + 71) : 128;
            const int elo = jlo - It0, nch = (jhi - jlo + 8) >> 3;
            const LAS unsigned char* tp = tbase + 64 * elo; const LAS unsigned char* zp = zbase + 512 * jlo;
            f32x4 acc[8]; bf16x8 R[8];
#pragma unroll
            for (int p = 0; p < 8; ++p) acc[p] = (f32x4){0.f, 0.f, 0.f, 0.f};
            R[0] = (bf16x8){0, 0, 0, 0, 0, 0, 0, 0};
#pragma unroll
            for (int k = 1; k < 8; ++k) R[k] = __builtin_bit_cast(bf16x8, *(const LAS u32x4_a4*)(tp + 64 * (k - 8)));
#pragma unroll 1
            for (int chn = 0; chn < nch; ++chn) {
#pragma unroll
                for (int k = 0; k < 8; ++k) {
                    R[k] = __builtin_bit_cast(bf16x8, *(const LAS u32x4_a4*)(tp + 64 * k));
                    const bf16x8 zf = *(const LAS bf16x8*)(zp + 512 * k);
#pragma unroll
                    for (int p = 0; p < 8; ++p) acc[p] = __builtin_amdgcn_mfma_f32_16x16x32_bf16(R[(k - p) & 7], zf, acc[p], 0, 0, 0); }
                tp += 512; zp += 4096; }
#pragma unroll
            for (int p = 0; p < 8; ++p) { const int q = 4 * (It0 + p) + 2 * sh + (gq >> 1); const size_t off = (size_t)(q * 8 + bb) * 8 + 4 * (gq & 1);
                const u32x2 xw = *(const u32x2*)(x0t + off);
                u32x2 w; w.x = cvt_pk_bf16(acc[p][0] * bf_lo(xw.x), acc[p][1] * bf_hi(xw.x)); w.y = cvt_pk_bf16(acc[p][2] * bf_lo(xw.y), acc[p][3] * bf_hi(xw.y));
                *(u32x2*)(yt + off) = w; }
        }
    }
    __syncthreads();
}

__device__ __forceinline__ void merge_attn(const Args& A) {
    const int tid = threadIdx.x, lane = tid & 63, wave = tid >> 6, gw = blockIdx.x * 8 + wave, NGW = gridDim.x * 8; unsigned char* ws = A.ws;
    const bf16_t* og = (const bf16_t*)(ws + WS_OG); const float* lse = (const float*)(ws + WS_LSE); bf16_t* y = (bf16_t*)(ws + WS_Y); const float* gain = A.in[17];
    const int head = lane >> 3, col = lane * 16;
    f32x4 gn[4];
#pragma unroll
    for (int k = 0; k < 4; ++k) gn[k] = *(const f32x4*)(gain + col + 4 * k);
    for (int tok = gw; tok < MTOK; tok += NGW) {
        float l[3], mxl = -3.0e38f;
#pragma unroll
        for (int g = 0; g < 3; ++g) { l[g] = lse[((size_t)g * MTOK + tok) * 8 + head]; mxl = fmaxf(mxl, l[g]); }
        float wsum = 0.f;
#pragma unroll
        for (int g = 0; g < 3; ++g) { l[g] = __expf(l[g] - mxl); wsum += l[g]; }
        const float iw = 1.0f / wsum; float v[16];
#pragma unroll
        for (int k = 0; k < 16; ++k) v[k] = 0.f;
#pragma unroll
        for (int g = 0; g < 3; ++g) { const float wg = l[g] * iw; const u32x4* src = (const u32x4*)(og + ((size_t)g * MTOK + tok) * AW + col);
#pragma unroll
            for (int k = 0; k < 2; ++k) { const u32x4 t = src[k];
                v[8 * k + 0] += wg * bf_lo(t.x); v[8 * k + 1] += wg * bf_hi(t.x); v[8 * k + 2] += wg * bf_lo(t.y); v[8 * k + 3] += wg * bf_hi(t.y);
                v[8 * k + 4] += wg * bf_lo(t.z); v[8 * k + 5] += wg * bf_hi(t.z); v[8 * k + 6] += wg * bf_lo(t.w); v[8 * k + 7] += wg * bf_hi(t.w); } }
        float ss = 0.f;
#pragma unroll
        for (int k = 0; k < 16; ++k) ss += v[k] * v[k];
        ss += __shfl_xor(ss, 1); ss += __shfl_xor(ss, 2); ss += __shfl_xor(ss, 4);
        const float r = 1.0f / sqrtf(ss * (1.0f / 128.0f) + EPS);
        u32x4 o0, o1;
        o0.x = cvt_pk_bf16(v[0] * r * gn[0][0], v[1] * r * gn[0][1]); o0.y = cvt_pk_bf16(v[2] * r * gn[0][2], v[3] * r * gn[0][3]);
        o0.z = cvt_pk_bf16(v[4] * r * gn[1][0], v[5] * r * gn[1][1]); o0.w = cvt_pk_bf16(v[6] * r * gn[1][2], v[7] * r * gn[1][3]);
        o1.x = cvt_pk_bf16(v[8] * r * gn[2][0], v[9] * r * gn[2][1]); o1.y = cvt_pk_bf16(v[10] * r * gn[2][2], v[11] * r * gn[2][3]);
        o1.z = cvt_pk_bf16(v[12] * r * gn[3][0], v[13] * r * gn[3][1]); o1.w = cvt_pk_bf16(v[14] * r * gn[3][2], v[15] * r * gn[3][3]);
        u32x4* dst = (u32x4*)(y + (size_t)tok * DM + col); dst[0] = o0; dst[1] = o1;
    }
}
__device__ __forceinline__ void hynorm_item(const Args& A, LAS unsigned char* lds, int item) {
    const int tid = threadIdx.x; unsigned char* ws = A.ws;
    const int grp = item >> 9, q = item & 511;
    LAS float* t = (LAS float*)lds;
    { const int c = tid >> 2, part = tid & 3; const u32x4* src = (const u32x4*)((const bf16_t*)(ws + WS_YT) + ((size_t)(grp * 128 + c) * 512 + q) * 64 + part * 16);
#pragma unroll
        for (int k = 0; k < 2; ++k) { const u32x4 v = src[k]; LAS float* d = t + c * 65 + part * 16 + 8 * k;
            d[0] = bf_lo(v.x); d[1] = bf_hi(v.x); d[2] = bf_lo(v.y); d[3] = bf_hi(v.y); d[4] = bf_lo(v.z); d[5] = bf_hi(v.z); d[6] = bf_lo(v.w); d[7] = bf_hi(v.w); } }
    __syncthreads();
    { const int pos = tid >> 3, p8 = tid & 7; float v[16], ss = 0.f;
#pragma unroll
        for (int k = 0; k < 16; ++k) { v[k] = t[(p8 * 16 + k) * 65 + pos]; ss += v[k] * v[k]; }
        ss += __shfl_xor(ss, 1); ss += __shfl_xor(ss, 2); ss += __shfl_xor(ss, 4);
        const float r = 1.0f / sqrtf(ss * (1.0f / 128.0f) + EPS); const float* gp = A.in[18] + grp * 128 + p8 * 16;
        unsigned w[8];
#pragma unroll
        for (int k = 0; k < 8; ++k) w[k] = cvt_pk_bf16(v[2 * k] * r * gp[2 * k], v[2 * k + 1] * r * gp[2 * k + 1]);
        const int b = pos >> 3, i8 = pos & 7; bf16_t* dst = (bf16_t*)(ws + WS_Y) + (size_t)(b * SEQ + 8 * q + i8) * DM + 1024 + grp * 128 + p8 * 16;
        ((u32x4*)dst)[0] = (u32x4){w[0], w[1], w[2], w[3]}; ((u32x4*)dst)[1] = (u32x4){w[4], w[5], w[6], w[7]}; }
    __syncthreads();
}

#define XB_TMO      128
#define XB_XCNT(j)  (256  + 64 * (j))
#define XB_XSUB(j)  (1280 + 64 * (j))
#define XB_XGEN(j)  (2304 + 64 * (j))
#define XB_TOP      3328
#define XB_TOPGEN   3392
#define XCD_BAR_WORDS 3456
#define XB_SPIN_CAP (1u << 18)
__device__ __forceinline__ unsigned xb_ld(unsigned* p)              { return __hip_atomic_load(p, __ATOMIC_RELAXED, __HIP_MEMORY_SCOPE_AGENT); }
__device__ __forceinline__ unsigned xb_add(unsigned* p, unsigned v) { return __hip_atomic_fetch_add(p, v, __ATOMIC_RELAXED, __HIP_MEMORY_SCOPE_AGENT); }
__device__ __forceinline__ unsigned xb_xcc_id() { return (unsigned)__builtin_amdgcn_s_getreg((3 << 11) | 20) & 0xFu; }
#define XB_SPIN(cond, bar) do { unsigned _sp = 0; while (cond) { __builtin_amdgcn_s_sleep(1); \
    if ((++_sp & 255u) == 0u) { if (xb_ld(&(bar)[XB_TMO])) break; if (_sp > XB_SPIN_CAP) { atomicAdd(&(bar)[XB_TMO], 1u); break; } } } } while (0)
struct XcdBarrier { unsigned* bar; unsigned x; volatile LAS unsigned* st; };
__device__ __forceinline__ XcdBarrier xcd_barrier_post(unsigned* bar, volatile LAS unsigned* st) {
    XcdBarrier b; b.bar = bar; b.x = xb_xcc_id(); b.st = st;
    if (threadIdx.x == 0) (void)xb_add(&bar[XB_XCNT(b.x)], 1u);
    return b;
}
__device__ __forceinline__ void xcd_barrier_complete(unsigned* bar, unsigned x, unsigned& nloc, unsigned& nx) {
    const unsigned G = gridDim.x * gridDim.y * gridDim.z;
    unsigned sum, cnt, mine, sp = 0u;
    for (;;) {
        sum = 0u; cnt = 0u; mine = 0u;
#pragma unroll
        for (unsigned j = 0; j < 16; ++j) { const unsigned c = xb_ld(&bar[XB_XCNT(j)]); sum += c; cnt += (c > 0u) ? 1u : 0u; mine = (j == x) ? c : mine; }
        if (sum == G) break;
        __builtin_amdgcn_s_sleep(1);
        if ((++sp & 255u) == 0u) { if (xb_ld(&bar[XB_TMO])) break; if (sp > XB_SPIN_CAP) { atomicAdd(&bar[XB_TMO], 1u); break; } }
    }
    nloc = mine > 0u ? mine : 1u; nx = cnt > 0u ? cnt : 1u;
}
__device__ __forceinline__ void xcd_barrier(const XcdBarrier& b) {
    asm volatile("s_waitcnt vmcnt(0)" ::: "memory");
    __syncthreads();
    if (threadIdx.x == 0) {
        unsigned* bar = b.bar;
        __builtin_amdgcn_s_waitcnt(0);
        unsigned nloc = b.st[0], nx = b.st[1];
        if (nloc == 0u) { xcd_barrier_complete(bar, b.x, nloc, nx); b.st[0] = nloc; b.st[1] = nx; }
        const unsigned old = xb_add(&bar[XB_XSUB(b.x)], 1u);
        const unsigned gen = old / nloc;
        if (old + 1u == (gen + 1u) * nloc) {
            __builtin_amdgcn_fence(__ATOMIC_RELEASE, "agent");
            asm volatile("s_waitcnt vmcnt(0)" ::: "memory");
            const unsigned og = xb_add(&bar[XB_TOP], 1u);
            const unsigned tg = og / nx;
            if (og + 1u == (tg + 1u) * nx) xb_add(&bar[XB_TOPGEN], 1u);
            else XB_SPIN(xb_ld(&bar[XB_TOPGEN]) == tg, bar);
            __builtin_amdgcn_fence(__ATOMIC_ACQUIRE, "agent");
            xb_add(&bar[XB_XGEN(b.x)], 1u);
            asm volatile("s_waitcnt vmcnt(0)" ::: "memory");
        } else {
            XB_SPIN(xb_ld(&bar[XB_XGEN(b.x)]) == gen, bar);
            __builtin_amdgcn_fence(__ATOMIC_ACQUIRE, "agent");
            asm volatile("s_waitcnt vmcnt(0)" ::: "memory");
        }
    }
    __syncthreads();
}

__global__ void __launch_bounds__(512, 2) fwd_mega(Args args) {
    extern __shared__ __attribute__((aligned(16))) unsigned char lds_raw[];
    LAS unsigned char* lds = (LAS unsigned char*)lds_raw;
    LAS float* xl = (LAS float*)(lds + XL_OFF);
    const int lo = args.ph_lo, hi = args.ph_hi, G = gridDim.x;
    unsigned char* ws = args.ws;
    volatile LAS unsigned* bst = (volatile LAS unsigned*)(lds + BARST_OFF);
    if (threadIdx.x < 2) bst[threadIdx.x] = 0u;
    __syncthreads();
    const XcdBarrier xbar = xcd_barrier_post((unsigned*)(ws + WS_BAR), bst);
#ifndef DUPMASK
#define DUPMASK 0
#endif
#define IN(k) (lo <= (k) && (k) < hi)
#define REP(k) for (int rep_ = 0; rep_ < (((DUPMASK >> (k)) & 1) ? 2 : 1); ++rep_, (rep_ < 2 && ((DUPMASK >> (k)) & 1)) ? cg::this_grid().sync() : (void)0)
#define SEAM(k) do { if (IN(k) && IN((k) + 1)) { if ((k) == 0) cg::this_grid().sync(); else xcd_barrier(xbar); } } while (0)
    if (IN(0)) REP(0) { p0_prologue(args, lds); } SEAM(0);
    if (IN(1)) { pg8::Gemm g{(const bf16_t*)(ws + WS_XB), (const bf16_t*)(ws + WS_WIN), MTOK, INW, DM}; pg8::StaticOrder S; S.init(MTOK, INW, G, (int)blockIdx.x);
        EpiIn E{ws, args.in[5], args.in[6]}; pg8::gemm_phase(lds, xl, g, S, E); } SEAM(1);
    if (IN(2)) REP(2) { attn_phase(args, lds);
        sconv_phase(args); } SEAM(2);
    if (IN(3)) REP(3) { for (int c = blockIdx.x; c < HW; c += G) lconv_item(args, lds, c); } SEAM(3);
    if (IN(4)) REP(4) { merge_attn(args); for (int it = blockIdx.x; it < 4096; it += G) hynorm_item(args, lds, it); } SEAM(4);
    if (IN(5)) { { pg8::Gemm g{(const bf16_t*)(ws + WS_Y), (const bf16_t*)(ws + WS_WOUT), MTOK, DM, DM}; pg8::StaticOrder S; S.init(MTOK, DM, G, (int)blockIdx.x);
            EpiOut E{args.in[0], (bf16_t*)(ws + WS_H1B), (float*)(ws + WS_SS1)}; pg8::gemm_phase(lds, xl, g, S, E); }
        { pg8::Gemm g{(const bf16_t*)(ws + WS_PB), (const bf16_t*)(ws + WS_WPROJ), MTOK, DM, PLE}; pg8::StaticOrder S; S.init(MTOK, DM, G, (int)blockIdx.x);
            EpiProj E{(bf16_t*)(ws + WS_ERAW), (float*)(ws + WS_SSE)}; pg8::gemm_phase(lds, xl, g, S, E); } } SEAM(5);
    if (IN(6)) { pg8::Gemm g{(const bf16_t*)(ws + WS_H1B), (const bf16_t*)(ws + WS_WGU), MTOK, 2 * FF, DM}; pg8::StaticOrder S; S.init(MTOK, 2 * FF, G, (int)blockIdx.x);
        EpiGU E{(bf16_t*)(ws + WS_ACT), (const float*)(ws + WS_SS1)}; pg8::gemm_phase(lds, xl, g, S, E); } SEAM(6);
    if (IN(7)) { pg8::Gemm g{(const bf16_t*)(ws + WS_ACT), (const bf16_t*)(ws + WS_WDOWN), MTOK, DM, FF}; pg8::StaticOrder S; S.init(MTOK, DM, G, (int)blockIdx.x);
        EpiDown E{(const bf16_t*)(ws + WS_H1B), (bf16_t*)(ws + WS_H2B), (float*)(ws + WS_SS2)}; pg8::gemm_phase(lds, xl, g, S, E); } SEAM(7);
    if (IN(8)) { pg8::Gemm g{(const bf16_t*)(ws + WS_H2B), (const bf16_t*)(ws + WS_WGATE), MTOK, DM, DM}; pg8::StaticOrder S; S.init(MTOK, DM, G, (int)blockIdx.x);
        EpiGate E{args.out, (const bf16_t*)(ws + WS_H2B), (const bf16_t*)(ws + WS_ERAW), (const float*)(ws + WS_SS2), (const float*)(ws + WS_SSE), args.in[26]}; pg8::gemm_phase(lds, xl, g, S, E); }
#undef IN
#undef SEAM
}

extern "C" void kernel_launch(void* const* d_in, const int* in_sizes, int n_in, void* d_out, int out_size, void* d_ws, size_t ws_size, hipStream_t stream) {
    static int grid = 0;
    if (grid == 0) {
        if (n_in != 27 || out_size != MTOK * DM || ws_size < WS_END) { fprintf(stderr, "kernel_launch: unexpected shapes (n_in %d out %d ws %zu)\n", n_in, out_size, ws_size); grid = -1; return; }
        int dev = 0, cus = 0, per_cu = 0;
        (void)hipGetDevice(&dev); (void)hipDeviceGetAttribute(&cus, hipDeviceAttributeMultiprocessorCount, dev);
        if (hipFuncSetAttribute((const void*)fwd_mega, hipFuncAttributeMaxDynamicSharedMemorySize, LDS_BYTES) != hipSuccess) { fprintf(stderr, "kernel_launch: hipFuncSetAttribute failed\n"); grid = -1; return; }
        if (hipOccupancyMaxActiveBlocksPerMultiprocessor(&per_cu, (const void*)fwd_mega, 512, LDS_BYTES) != hipSuccess || per_cu < 1) { fprintf(stderr, "kernel_launch: occupancy query says %d\n", per_cu); per_cu = 1; }
        (void)hipGetLastError();
        grid = cus * per_cu;
    }
    if (grid < 0) return;
    Args a{};
    for (int i = 0; i < 27; ++i) a.in[i] = (const float*)d_in[i];
    a.out = (float*)d_out; a.ws = (unsigned char*)d_ws;
#if ONE_LAUNCH
    (void)hipMemsetAsync((unsigned char*)d_ws + WS_BAR, 0, XCD_BAR_WORDS * 4, stream);
    a.ph_lo = 0; a.ph_hi = NPH;
    void* kargs[] = {&a};
    hipError_t e = hipLaunchCooperativeKernel((const void*)fwd_mega, dim3(grid), dim3(512), kargs, LDS_BYTES, stream);
    if (e != hipSuccess) fprintf(stderr, "kernel_launch: cooperative launch failed: %s (grid %d)\n", hipGetErrorString(e), grid);
#else
    for (int ph = 0; ph < NPH; ++ph) { a.ph_lo = ph; a.ph_hi = ph + 1; hipLaunchKernelGGL(fwd_mega, dim3(grid), dim3(512), LDS_BYTES, stream, a); }
#endif
}
```

```cpp
#include <hip/hip_runtime.h>
#include <hip/hip_cooperative_groups.h>
#include <cstdio>
#include <cstdint>
namespace cg = cooperative_groups;

#ifndef ONE_LAUNCH
#define ONE_LAUNCH 1
#endif

#define LAS __attribute__((address_space(3)))
typedef unsigned short bf16_t;
typedef short bf16x8 __attribute__((ext_vector_type(8)));
typedef short s16x4 __attribute__((ext_vector_type(4)));
typedef float f32x4 __attribute__((ext_vector_type(4)));
typedef unsigned u32x4 __attribute__((ext_vector_type(4)));
typedef unsigned u32x2 __attribute__((ext_vector_type(2)));
typedef u32x4 u32x4_a4 __attribute__((aligned(4)));

__device__ __forceinline__ unsigned cvt_pk_bf16(float lo, float hi) { unsigned r; asm volatile("v_cvt_pk_bf16_f32 %0, %1, %2" : "=v"(r) : "v"(lo), "v"(hi)); return r; }
__device__ __forceinline__ float bf_lo(unsigned w) { return __uint_as_float(w << 16); }
__device__ __forceinline__ float bf_hi(unsigned w) { return __uint_as_float(w & 0xffff0000u); }
__device__ __forceinline__ float dot4(f32x4 a) { return (a[0] * a[0] + a[1] * a[1]) + (a[2] * a[2] + a[3] * a[3]); }

namespace pg8 {
#define PG8_LAS __attribute__((address_space(3)))
constexpr int BM = 256, BK = 64, HALF = 128, HTB = HALF * BK * 2, STAGE_BYTES = 8 * HTB, NXCD = 8, WGM = 8;
__host__ __device__ __forceinline__ int lds_byte(int r, int c) { const int st = (r >> 4) * 2 + (c >> 5), rr = r & 15, cc = c & 31, ob = rr * 64 + cc * 2; return st * 1024 + (ob ^ (((ob >> 9) & 1) << 5)); }
__host__ __device__ __forceinline__ void stage_rc(int b, int& R, int& C) { const int st = b / 1024, sb = b % 1024, swz = sb ^ (((sb >> 9) & 1) << 5); R = (st >> 1) * 16 + swz / 64; C = (st & 1) * 32 + (swz % 64) / 2; }
__host__ __device__ __forceinline__ int perm32(int rho) { const int n = rho >> 4, i = rho & 15; return 8 * (i >> 2) + 4 * n + (i & 3); }
struct Unit { int pm, pn; };
struct Gemm { const bf16_t* A; const bf16_t* Bt; int M, N, K; };
struct StaticOrder {
    int nM, nN, nwg, G, c;
    __host__ __device__ void init(int M, int N, int G_, int c_) { nM = M / BM; nN = N / BM; nwg = nM * nN; G = G_; c = c_; }
    __host__ __device__ bool next(int i, Unit& u) const {
        const long L = (long)i * G + c; if (L >= nwg) return false;
        int wgid = (int)L; { const int q = nwg / NXCD, r = nwg % NXCD, xcd = wgid % NXCD, off = wgid / NXCD; wgid = (xcd < r ? xcd * (q + 1) : r * (q + 1) + (xcd - r) * q) + off; }
        const int nig = WGM * nN, gid = wgid / nig, fm = gid * WGM, gsz = (nM - fm) < WGM ? (nM - fm) : WGM;
        u.pm = fm + ((wgid % nig) % gsz); u.pn = (wgid % nig) / gsz; return true;
    }
};
template <class Epi>
__device__ __forceinline__ void gemm_phase(PG8_LAS unsigned char* lds, PG8_LAS float* xl, const Gemm g, const StaticOrder& S, const Epi& E) {
    const int tid = threadIdx.x, wid = __builtin_amdgcn_readfirstlane(tid >> 6), lane = tid & 63, wr = wid >> 2, wc = wid & 3, fr = lane & 15, fq = lane >> 4;
    const int K = g.K, nt = K / BK;
    unsigned voffA[2], voffB[2];
#pragma unroll
    for (int i = 0; i < 2; ++i) { int R, C; stage_rc(tid * 16 + i * 8192, R, C); const int Rb = (R & ~31) + perm32(R & 31);
        voffA[i] = (unsigned)(R * K + C) * 2u; voffB[i] = (unsigned)(Rb * K + C) * 2u; }
    const size_t kstep = (size_t)(BK * 2);
    const size_t hstep = (size_t)HALF * K * 2;
    const size_t tstep = 2 * hstep;
    const unsigned ldsw = (unsigned)wid * 1024u;
    const int aoff = lds_byte(wr * 64 + fr, fq * 8), boff = lds_byte(wc * 32 + fr, fq * 8);
#define PG8_SA(b, h) (((b) * 2 + (h)) * HTB)
#define PG8_SB(b, h) ((4 + (b) * 2 + (h)) * HTB)
#define PG8_STAGE(bufoff, gbase, voff) do { _Pragma("unroll") for (int _i = 0; _i < 2; ++_i) \
        __builtin_amdgcn_global_load_lds((const unsigned*)((const char*)(gbase) + (voff)[_i]), (PG8_LAS unsigned*)(lds + (bufoff) + ldsw + _i * 8192), 16, 0, 0); } while (0)
#define PG8_LDA(dst, b, h) do { _Pragma("unroll") for (int m = 0; m < 4; ++m) _Pragma("unroll") for (int k = 0; k < 2; ++k) dst[m][k] = *(const PG8_LAS bf16x8*)(lds + PG8_SA(b, h) + aoff + m * 2048 + k * 1024); } while (0)
#define PG8_LDB(dst, b, h) do { _Pragma("unroll") for (int n = 0; n < 2; ++n) _Pragma("unroll") for (int k = 0; k < 2; ++k) dst[n][k] = *(const PG8_LAS bf16x8*)(lds + PG8_SB(b, h) + boff + n * 2048 + k * 1024); } while (0)
#define PG8_MMA(ai, bj, At, Bt) do { __builtin_amdgcn_s_setprio(1); _Pragma("unroll") for (int m = 0; m < 4; ++m) _Pragma("unroll") for (int n = 0; n < 2; ++n) _Pragma("unroll") for (int k = 0; k < 2; ++k) \
        acc[ai][bj][m][n] = __builtin_amdgcn_mfma_f32_16x16x32_bf16(Bt[n][k], At[m][k], acc[ai][bj][m][n], 0, 0, 0); __builtin_amdgcn_s_setprio(0); } while (0)
#define PG8_WAIT_V(n) asm volatile("s_waitcnt vmcnt(" #n ")" ::: "memory")
#define PG8_WAIT_L(n) asm volatile("s_waitcnt lgkmcnt(" #n ")" ::: "memory")
#define PG8_BAR __builtin_amdgcn_s_barrier()
#define PG8_SCHED __builtin_amdgcn_sched_barrier(0)
    Unit cur, nxt; int ui = 0;
    if (!S.next(0, cur)) return;
    f32x4 acc[2][2][4][2];
#pragma unroll
    for (int a = 0; a < 2; ++a)
#pragma unroll
        for (int b = 0; b < 2; ++b)
#pragma unroll
            for (int m = 0; m < 4; ++m)
#pragma unroll
                for (int n = 0; n < 2; ++n) acc[a][b][m][n] = (f32x4){0.f, 0.f, 0.f, 0.f};
    bf16x8 At[4][2], B0[2][2], B1[2][2];
    const char* cA = (const char*)g.A + (size_t)cur.pm * tstep; const char* cB = (const char*)g.Bt + (size_t)cur.pn * tstep;
    PG8_STAGE(PG8_SB(0, 0), cB, voffB); PG8_STAGE(PG8_SB(0, 1), cB + hstep, voffB); PG8_STAGE(PG8_SA(0, 0), cA, voffA); PG8_STAGE(PG8_SA(0, 1), cA + hstep, voffA);
    if (wr == 1) PG8_BAR;
    PG8_WAIT_V(2); PG8_BAR;
    PG8_STAGE(PG8_SB(1, 0), cB + kstep, voffB); PG8_STAGE(PG8_SA(1, 0), cA + kstep, voffA); PG8_STAGE(PG8_SB(1, 1), cB + hstep + kstep, voffB);
    PG8_WAIT_V(6); PG8_BAR;
    for (;;) {
        const bool has_next = S.next(ui + 1, nxt);
        const char* nA = has_next ? (const char*)g.A + (size_t)nxt.pm * tstep : cA; const char* nB = has_next ? (const char*)g.Bt + (size_t)nxt.pn * tstep : cB;
        for (int t = 0; t < nt; t += 2) {
            const bool last = (t == nt - 2);
            const char* a1 = cA + (size_t)(t + 1) * kstep;
            const char* a2 = last ? nA : cA + (size_t)(t + 2) * kstep; const char* b2 = last ? nB : cB + (size_t)(t + 2) * kstep;
            const char* a3 = a2 + kstep; const char* b3 = b2 + kstep;
            PG8_LDB(B0, 0, 0); PG8_LDB(B1, 0, 1); PG8_SCHED; PG8_LDA(At, 0, 0); PG8_STAGE(PG8_SA(1, 1), a1 + hstep, voffA);
            PG8_WAIT_V(8); PG8_WAIT_L(0); PG8_BAR; PG8_MMA(0, 0, At, B0); PG8_MMA(0, 1, At, B1); PG8_BAR; PG8_SCHED;
            PG8_LDA(At, 0, 1); PG8_STAGE(PG8_SB(0, 0), b2, voffB); PG8_STAGE(PG8_SB(0, 1), b2 + hstep, voffB); PG8_STAGE(PG8_SA(0, 0), a2, voffA);
            PG8_WAIT_V(8); PG8_WAIT_L(0); PG8_BAR; PG8_MMA(1, 0, At, B0); PG8_MMA(1, 1, At, B1); PG8_BAR; PG8_SCHED;
            PG8_LDB(B0, 1, 0); PG8_LDB(B1, 1, 1); PG8_SCHED; PG8_LDA(At, 1, 0); PG8_STAGE(PG8_SA(0, 1), a2 + hstep, voffA);
            PG8_WAIT_V(8); PG8_WAIT_L(0); PG8_BAR; PG8_MMA(0, 0, At, B0); PG8_MMA(0, 1, At, B1); PG8_BAR; PG8_SCHED;
            PG8_LDA(At, 1, 1); PG8_STAGE(PG8_SB(1, 0), b3, voffB); PG8_STAGE(PG8_SB(1, 1), b3 + hstep, voffB); PG8_STAGE(PG8_SA(1, 0), a3, voffA);
            PG8_WAIT_V(8); PG8_WAIT_L(0); PG8_BAR; PG8_MMA(1, 0, At, B0); PG8_MMA(1, 1, At, B1); PG8_BAR; PG8_SCHED;
        }
        if (wr == 0) PG8_BAR;
        E(acc, cur, wr, wc, fr, fq, xl);
        if (!has_next) break;
#pragma unroll
        for (int a = 0; a < 2; ++a)
#pragma unroll
            for (int b = 0; b < 2; ++b)
#pragma unroll
                for (int m = 0; m < 4; ++m)
#pragma unroll
                    for (int n = 0; n < 2; ++n) acc[a][b][m][n] = (f32x4){0.f, 0.f, 0.f, 0.f};
        cur = nxt; cA = nA; cB = nB; ++ui;
        if (wr == 1) PG8_BAR;
    }
    PG8_WAIT_V(0);
    PG8_BAR;
#undef PG8_SA
#undef PG8_SB
#undef PG8_STAGE
#undef PG8_LDA
#undef PG8_LDB
#undef PG8_MMA
#undef PG8_WAIT_V
#undef PG8_WAIT_L
#undef PG8_BAR
#undef PG8_SCHED
}
}

constexpr int MTOK = 32768, DM = 2048, SEQ = 4096, NB = 8, INW = 6144, FF = 5632, PLE = 256, AW = 1024, HW = 1024;
constexpr float EPS = 1e-6f;
constexpr size_t MiB = (size_t)1 << 20;
constexpr size_t WS_WIN = 0, WS_WOUT = 24 * MiB, WS_WGU = 32 * MiB, WS_WDOWN = 76 * MiB, WS_WGATE = 98 * MiB, WS_WPROJ = 106 * MiB;
constexpr size_t WS_HR = 107 * MiB;
constexpr size_t WS_SMALL = 124 * MiB;
constexpr size_t WS_RSTDX = WS_SMALL, WS_SSE = WS_SMALL + 128 * 1024, WS_SS1 = WS_SMALL + 256 * 1024, WS_SS2 = WS_SMALL + 384 * 1024, WS_BTAB = WS_SMALL + 512 * 1024, WS_LSE = WS_SMALL + MiB;
constexpr size_t WS_BAR = WS_SMALL + 640 * 1024;
constexpr size_t WS_OG = 128 * MiB, WS_ERAW = 128 * MiB, WS_XB = 256 * MiB, WS_H2B = 256 * MiB, WS_PB = 384 * MiB;
constexpr size_t WS_Q = 400 * MiB, WS_K = 464 * MiB, WS_V = 528 * MiB, WS_YT = 400 * MiB, WS_H1B = 464 * MiB;
constexpr size_t WS_HY = 592 * MiB, WS_Y = 592 * MiB, WS_ACT = 592 * MiB, WS_ZT = 784 * MiB, WS_X0T = 848 * MiB, WS_END = 944 * MiB;
constexpr int HRLEN = 8320, HROFF = 4160;
constexpr int LDS_BYTES = 155648;
constexpr int XL_OFF = 131072, BARST_OFF = LDS_BYTES - 16;
constexpr int NPH = 9;

struct Args { const float* in[27]; float* out; unsigned char* ws; int ph_lo, ph_hi; };

using pg8::Unit;
struct EpiIn {
    unsigned char* ws; const float* qg; const float* kg;
    __device__ __forceinline__ void operator()(const f32x4 (&acc)[2][2][4][2], const Unit& u, int wr, int wc, int fr, int fq, LAS float* P) const {
        const float* rstd = (const float*)(ws + WS_RSTDX);
        const int rowl0 = wr * 64 + fr, row0 = u.pm * 256 + rowl0;
        if (u.pn < 8) {
#pragma unroll
            for (int ai = 0; ai < 2; ++ai)
#pragma unroll
                for (int m = 0; m < 4; ++m) { const float rs = rstd[row0 + ai * 128 + m * 16];
#pragma unroll
                    for (int bj = 0; bj < 2; ++bj) { float s = (dot4(acc[ai][bj][m][0]) + dot4(acc[ai][bj][m][1])) * rs * rs;
                        s += __shfl_xor(s, 16); s += __shfl_xor(s, 32);
                        if (fq == 0) P[((rowl0 + ai * 128 + m * 16) * 2 + bj) * 4 + wc] = s; } }
            asm volatile("s_waitcnt lgkmcnt(0)" ::: "memory"); __builtin_amdgcn_s_barrier(); asm volatile("" ::: "memory");
            const bool isq = u.pn < 4; const float* gp = (isq ? qg : kg) + wc * 32 + fq * 8; const float sc = isq ? 0.08838834764831845f : 1.0f;
            const f32x4 g0 = *(const f32x4*)gp * sc, g1 = *(const f32x4*)(gp + 4) * sc;
            bf16_t* base = (bf16_t*)(ws + (isq ? WS_Q : WS_K)) + (u.pn & 3) * 256 + wc * 32 + fq * 8;
#pragma unroll
            for (int ai = 0; ai < 2; ++ai)
#pragma unroll
                for (int m = 0; m < 4; ++m) { const int rl = rowl0 + ai * 128 + m * 16; const float rs = rstd[row0 + ai * 128 + m * 16];
#pragma unroll
                    for (int bj = 0; bj < 2; ++bj) { const f32x4 pp = *(const LAS f32x4*)(P + (rl * 2 + bj) * 4);
                        const float tot = (pp[0] + pp[1]) + (pp[2] + pp[3]); const float r = rs * __builtin_amdgcn_rsqf(tot * (1.0f / 128.0f) + EPS);
                        const f32x4 v0 = acc[ai][bj][m][0] * r * g0, v1 = acc[ai][bj][m][1] * r * g1;
                        u32x4 w; w.x = cvt_pk_bf16(v0[0], v0[1]); w.y = cvt_pk_bf16(v0[2], v0[3]); w.z = cvt_pk_bf16(v1[0], v1[1]); w.w = cvt_pk_bf16(v1[2], v1[3]);
                        *(u32x4*)(base + (size_t)(u.pm * 256 + rl) * 1024 + bj * 128) = w; } }
        } else {
            const bool isv = u.pn < 12; const int ld = isv ? 1024 : 3072;
            bf16_t* base = (bf16_t*)(ws + (isv ? WS_V : WS_HY)) + (isv ? (u.pn - 8) : (u.pn - 12)) * 256 + wc * 32 + fq * 8;
#pragma unroll
            for (int ai = 0; ai < 2; ++ai)
#pragma unroll
                for (int m = 0; m < 4; ++m) { const int row = row0 + ai * 128 + m * 16; const float rs = rstd[row];
#pragma unroll
                    for (int bj = 0; bj < 2; ++bj) { const f32x4 v0 = acc[ai][bj][m][0] * rs, v1 = acc[ai][bj][m][1] * rs;
                        u32x4 w; w.x = cvt_pk_bf16(v0[0], v0[1]); w.y = cvt_pk_bf16(v0[2], v0[3]); w.z = cvt_pk_bf16(v1[0], v1[1]); w.w = cvt_pk_bf16(v1[2], v1[3]);
                        *(u32x4*)(base + (size_t)row * ld + bj * 128) = w; } }
        }
    }
};
struct EpiOut {
    const float* base; bf16_t* ob; float* ss;
    __device__ __forceinline__ void operator()(const f32x4 (&acc)[2][2][4][2], const Unit& u, int wr, int wc, int fr, int fq, LAS float*) const {
        const int row0 = u.pm * 256 + wr * 64 + fr, col0 = u.pn * 256 + wc * 32 + fq * 8;
#pragma unroll
        for (int ai = 0; ai < 2; ++ai)
#pragma unroll
            for (int m = 0; m < 4; ++m) { const int row = row0 + ai * 128 + m * 16; float s = 0.f;
#pragma unroll
                for (int bj = 0; bj < 2; ++bj) { const size_t off = (size_t)row * DM + col0 + bj * 128;
                    const f32x4 h0 = *(const f32x4*)(base + off) + acc[ai][bj][m][0], h1 = *(const f32x4*)(base + off + 4) + acc[ai][bj][m][1];
                    u32x4 w; w.x = cvt_pk_bf16(h0[0], h0[1]); w.y = cvt_pk_bf16(h0[2], h0[3]); w.z = cvt_pk_bf16(h1[0], h1[1]); w.w = cvt_pk_bf16(h1[2], h1[3]);
                    *(u32x4*)(ob + off) = w; s += dot4(h0) + dot4(h1); }
                s += __shfl_xor(s, 16); s += __shfl_xor(s, 32);
                if (fq == 0) atomicAdd(ss + row, s);
                asm volatile("" ::: "memory"); }
    }
};
struct EpiDown {
    const bf16_t* hb; bf16_t* ob; float* ss;
    __device__ __forceinline__ void operator()(const f32x4 (&acc)[2][2][4][2], const Unit& u, int wr, int wc, int fr, int fq, LAS float*) const {
        const int row0 = u.pm * 256 + wr * 64 + fr, col0 = u.pn * 256 + wc * 32 + fq * 8;
#pragma unroll
        for (int ai = 0; ai < 2; ++ai)
#pragma unroll
            for (int m = 0; m < 4; ++m) { const int row = row0 + ai * 128 + m * 16; float s = 0.f;
#pragma unroll
                for (int bj = 0; bj < 2; ++bj) { const size_t off = (size_t)row * DM + col0 + bj * 128; const u32x4 hw = *(const u32x4*)(hb + off);
                    const f32x4 h0 = (f32x4){bf_lo(hw.x), bf_hi(hw.x), bf_lo(hw.y), bf_hi(hw.y)} + acc[ai][bj][m][0], h1 = (f32x4){bf_lo(hw.z), bf_hi(hw.z), bf_lo(hw.w), bf_hi(hw.w)} + acc[ai][bj][m][1];
                    u32x4 w; w.x = cvt_pk_bf16(h0[0], h0[1]); w.y = cvt_pk_bf16(h0[2], h0[3]); w.z = cvt_pk_bf16(h1[0], h1[1]); w.w = cvt_pk_bf16(h1[2], h1[3]);
                    *(u32x4*)(ob + off) = w; s += dot4(h0) + dot4(h1); }
                s += __shfl_xor(s, 16); s += __shfl_xor(s, 32);
                if (fq == 0) atomicAdd(ss + row, s);
                asm volatile("" ::: "memory"); }
    }
};
struct EpiProj {
    bf16_t* ob; float* ss;
    __device__ __forceinline__ void operator()(const f32x4 (&acc)[2][2][4][2], const Unit& u, int wr, int wc, int fr, int fq, LAS float*) const {
        const int row0 = u.pm * 256 + wr * 64 + fr, col0 = u.pn * 256 + wc * 32 + fq * 8;
#pragma unroll
        for (int ai = 0; ai < 2; ++ai)
#pragma unroll
            for (int m = 0; m < 4; ++m) { const int row = row0 + ai * 128 + m * 16; float s = 0.f;
#pragma unroll
                for (int bj = 0; bj < 2; ++bj) { const size_t off = (size_t)row * DM + col0 + bj * 128; const f32x4 h0 = acc[ai][bj][m][0], h1 = acc[ai][bj][m][1];
                    u32x4 w; w.x = cvt_pk_bf16(h0[0], h0[1]); w.y = cvt_pk_bf16(h0[2], h0[3]); w.z = cvt_pk_bf16(h1[0], h1[1]); w.w = cvt_pk_bf16(h1[2], h1[3]);
                    *(u32x4*)(ob + off) = w; s += dot4(h0) + dot4(h1); }
                s += __shfl_xor(s, 16); s += __shfl_xor(s, 32);
                if (fq == 0) atomicAdd(ss + row, s); }
    }
};
struct EpiGU {
    bf16_t* act; const float* ss;
    __device__ __forceinline__ void operator()(const f32x4 (&acc)[2][2][4][2], const Unit& u, int wr, int wc, int fr, int fq, LAS float*) const {
        const int row0 = u.pm * 256 + wr * 64 + fr, col0 = u.pn * 128 + wc * 32 + fq * 8;
#pragma unroll
        for (int ai = 0; ai < 2; ++ai)
#pragma unroll
            for (int m = 0; m < 4; ++m) { const int row = row0 + ai * 128 + m * 16; const float rs = __builtin_amdgcn_rsqf(ss[row] * (1.0f / DM) + EPS);
                float o[8];
#pragma unroll
                for (int n = 0; n < 2; ++n)
#pragma unroll
                    for (int j = 0; j < 4; ++j) { const float a = acc[ai][0][m][n][j] * rs, gg = acc[ai][1][m][n][j] * rs;
                        o[n * 4 + j] = a * __builtin_amdgcn_rcpf(1.0f + __expf(-a)) * gg; }
                u32x4 w; w.x = cvt_pk_bf16(o[0], o[1]); w.y = cvt_pk_bf16(o[2], o[3]); w.z = cvt_pk_bf16(o[4], o[5]); w.w = cvt_pk_bf16(o[6], o[7]);
                *(u32x4*)(act + (size_t)row * FF + col0) = w; }
    }
};
struct EpiGate {
    float* out; const bf16_t* hb; const bf16_t* eraw; const float* ss2; const float* ssE; const float* post;
    __device__ __forceinline__ void operator()(const f32x4 (&acc)[2][2][4][2], const Unit& u, int wr, int wc, int fr, int fq, LAS float*) const {
        const int row0 = u.pm * 256 + wr * 64 + fr, col0 = u.pn * 256 + wc * 32 + fq * 8;
#pragma unroll
        for (int ai = 0; ai < 2; ++ai)
#pragma unroll
            for (int m = 0; m < 4; ++m) { const int row = row0 + ai * 128 + m * 16;
                const float rs2 = __builtin_amdgcn_rsqf(ss2[row] * (1.0f / DM) + EPS), rsE = __builtin_amdgcn_rsqf(ssE[row] * (1.0f / DM) + EPS);
#pragma unroll
                for (int bj = 0; bj < 2; ++bj) { const size_t off = (size_t)row * DM + col0 + bj * 128;
                    const u32x4 ew = *(const u32x4*)(eraw + off); const f32x4 p0 = *(const f32x4*)(post + col0 + bj * 128), p1 = *(const f32x4*)(post + col0 + bj * 128 + 4);
                    const f32x4 e0 = (f32x4){bf_lo(ew.x), bf_hi(ew.x), bf_lo(ew.y), bf_hi(ew.y)} * rsE * p0, e1 = (f32x4){bf_lo(ew.z), bf_hi(ew.z), bf_lo(ew.w), bf_hi(ew.w)} * rsE * p1;
                    const u32x4 hw = *(const u32x4*)(hb + off);
                    f32x4 h0 = (f32x4){bf_lo(hw.x), bf_hi(hw.x), bf_lo(hw.y), bf_hi(hw.y)}, h1 = (f32x4){bf_lo(hw.z), bf_hi(hw.z), bf_lo(hw.w), bf_hi(hw.w)};
#pragma unroll
                    for (int j = 0; j < 4; ++j) { h0[j] += __builtin_amdgcn_rcpf(1.0f + __expf(-acc[ai][bj][m][0][j] * rs2)) * e0[j]; h1[j] += __builtin_amdgcn_rcpf(1.0f + __expf(-acc[ai][bj][m][1][j] * rs2)) * e1[j]; }
                    *(f32x4*)(out + off) = h0; *(f32x4*)(out + off + 4) = h1; }
                asm volatile("" ::: "memory"); }
    }
};

__device__ __forceinline__ void p0_transpose_blk(const float* W, const float* gain, int K, int N, bf16_t* WT, int gu, LAS unsigned char* T, int item) {
    const int tid = threadIdx.x, lane = tid & 63, w = __builtin_amdgcn_readfirstlane(tid >> 6);
    const int nblk = N / 256, kb = item / nblk, nb = item % nblk, k0 = 64 * kb, n0 = 256 * nb;
    f32x4 v[8];
#pragma unroll
    for (int i = 0; i < 8; ++i) v[i] = *(const f32x4*)(W + (size_t)(k0 + 8 * w + i) * N + n0 + 4 * lane);
    if (gain) {
#pragma unroll
        for (int i = 0; i < 8; ++i) v[i] *= gain[k0 + 8 * w + i]; }
#pragma unroll
    for (int j = 0; j < 4; ++j) { u32x4 o; o.x = cvt_pk_bf16(v[0][j], v[1][j]); o.y = cvt_pk_bf16(v[2][j], v[3][j]); o.z = cvt_pk_bf16(v[4][j], v[5][j]); o.w = cvt_pk_bf16(v[6][j], v[7][j]);
        *(LAS u32x4*)(T + (4 * lane + j) * 128 + ((w ^ (lane & 7)) * 16)) = o; }
    __syncthreads();
    int ndb = n0;
    if (gu) { const int s = n0 >= FF ? 1 : 0, j = n0 - s * FF; ndb = 256 * (j >> 7) + 128 * s; }
#pragma unroll
    for (int i = 0; i < 4; ++i) { const int id = tid + 512 * i, n = id >> 3, c = id & 7;
        const u32x4 o = *(const LAS u32x4*)(T + n * 128 + ((c ^ ((n >> 2) & 7)) * 16));
        const int nd = gu ? (ndb + 256 * (n >> 7) + (n & 127)) : (n0 + n);
        *(u32x4*)(WT + (size_t)nd * K + k0 + 8 * c) = o; }
    __syncthreads();
}
__device__ __forceinline__ float wave_sum(float v) {
#pragma unroll
    for (int o = 1; o < 64; o <<= 1) v += __shfl_xor(v, o);
    return v;
}
__device__ __forceinline__ int t5_bucket(int rel) {
    const int n = rel < 0 ? -rel : rel;
    int large = 8 + (int)(logf((float)(n < 1 ? 1 : n) / 8.0f) / logf(128.0f) * 8.0f);
    if (large > 15) large = 15;
    return (rel > 0 ? 16 : 0) + (n < 8 ? n : large);
}
__device__ __forceinline__ void p0_prologue(const Args& A, LAS unsigned char* lds) {
    const int tid = threadIdx.x, lane = tid & 63, wave = tid >> 6, G = gridDim.x, gw = blockIdx.x * 8 + wave, NGW = G * 8;
    unsigned char* ws = A.ws;
    {
        constexpr int I_IN = 32 * 24, I_OUT = 32 * 8, I_GU = 32 * 44, I_DN = 88 * 8, I_GT = 32 * 8, I_PJ = 4 * 8;
        constexpr int NIT = I_IN + I_OUT + I_GU + I_DN + I_GT + I_PJ;
        for (int it = blockIdx.x; it < NIT; it += G) {
            int r = it;
            if (r < I_IN) { p0_transpose_blk(A.in[4], A.in[3], DM, INW, (bf16_t*)(ws + WS_WIN), 0, lds, r); continue; } r -= I_IN;
            if (r < I_OUT) { p0_transpose_blk(A.in[19], nullptr, DM, DM, (bf16_t*)(ws + WS_WOUT), 0, lds, r); continue; } r -= I_OUT;
            if (r < I_GU) { p0_transpose_blk(A.in[21], A.in[20], DM, 2 * FF, (bf16_t*)(ws + WS_WGU), 1, lds, r); continue; } r -= I_GU;
            if (r < I_DN) { p0_transpose_blk(A.in[22], nullptr, FF, DM, (bf16_t*)(ws + WS_WDOWN), 0, lds, r); continue; } r -= I_DN;
            if (r < I_GT) { p0_transpose_blk(A.in[24], A.in[23], DM, DM, (bf16_t*)(ws + WS_WGATE), 0, lds, r); continue; } r -= I_GT;
            p0_transpose_blk(A.in[25], nullptr, PLE, DM, (bf16_t*)(ws + WS_WPROJ), 0, lds, r);
        }
    }
    {
        const float* x = A.in[0]; bf16_t* xb = (bf16_t*)(ws + WS_XB); float* rstd = (float*)(ws + WS_RSTDX);
        for (int m = gw; m < MTOK; m += NGW) {
            const f32x4* xr = (const f32x4*)(x + (size_t)m * DM) + lane; f32x4 v[8]; float s = 0.f;
#pragma unroll
            for (int j = 0; j < 8; ++j) { v[j] = xr[64 * j]; s += dot4(v[j]); }
            s = wave_sum(s);
            if (lane == 0) rstd[m] = 1.0f / sqrtf(s * (1.0f / DM) + EPS);
            u32x2* o = (u32x2*)(xb + (size_t)m * DM) + lane;
#pragma unroll
            for (int j = 0; j < 8; ++j) { u32x2 w; w.x = cvt_pk_bf16(v[j][0], v[j][1]); w.y = cvt_pk_bf16(v[j][2], v[j][3]); o[64 * j] = w; }
        }
    }
    {
        const size_t gt = (size_t)blockIdx.x * 512 + tid, NT = (size_t)G * 512;
        const f32x4* p4 = (const f32x4*)A.in[1]; u32x2* pb = (u32x2*)(ws + WS_PB);
        _Pragma("unroll 4") for (size_t i = gt; i < (size_t)MTOK * PLE / 4; i += NT) { const f32x4 v = p4[i]; u32x2 w; w.x = cvt_pk_bf16(v[0], v[1]); w.y = cvt_pk_bf16(v[2], v[3]); pb[i] = w; }
        float* z = (float*)(ws + WS_SSE);
        for (size_t i = gt; i < 3 * (size_t)MTOK; i += NT) z[i] = 0.f;
        if (blockIdx.x == 0) { float* bt = (float*)(ws + WS_BTAB); const float* rb = A.in[2];
            for (int i = tid; i < 3 * 8 * 129; i += 512) { const int g = i / (8 * 129), h = (i / 129) % 8, rel = i % 129 - 64; const int d = g == 0 ? 1 : (g == 1 ? 4 : 16);
                bt[i] = rb[t5_bucket(rel * d) * 8 + h]; } }
    }
    {
        LAS float* zf = (LAS float*)lds;
        LAS float* hA = zf + 16 * 33;
        LAS float* hB = hA + 16 * 64;
        const float* w1 = A.in[9]; const float* b1 = A.in[10]; const float* wi = A.in[11]; const float* bi = A.in[12]; const float* wo = A.in[13];
        const float* fq = A.in[14]; const float* dec = A.in[15]; const float* hb = A.in[16];
        bf16_t* hr = (bf16_t*)(ws + WS_HR);
        __syncthreads();
        for (int z = blockIdx.x; z < 263; z += G) { const int q = z < 132 ? z : z + 257;
            for (int c = tid; c < HW; c += 512) { u32x4* d = (u32x4*)(hr + (size_t)c * HRLEN + 16 * q); d[0] = (u32x4){0u, 0u, 0u, 0u}; d[1] = (u32x4){0u, 0u, 0u, 0u}; } }
        for (int r = blockIdx.x; r < 256; r += G) {
            const bool edge = (r == 255);
#define FPOS(sl) (edge ? ((sl) < 15 ? 4095 - (sl) : 0) : (HROFF + 2048 - (16 * (133 + r) + (sl))))
            for (int t = tid; t < 16 * 33; t += 512) { const int pi = t / 33, f = t % 33; const float pos = (float)FPOS(pi); float v;
                if (f == 0) v = pos / 4095.0f;
                else { const int k = (f - 1) & 15; const float fr = 1e-4f + (float)k * ((15.0f - 1e-4f) / 15.0f); const float ang = ((float)(2.0 * 3.14159265358979323846 / 4096.0) * pos) * fr;
                    v = (f <= 16) ? cosf(ang) : -sinf(ang); }
                zf[t] = v; }
            __syncthreads();
#pragma unroll
            for (int h2 = 0; h2 < 2; ++h2) { const int e = tid + 512 * h2, pi = e >> 6, uu = e & 63; float sacc = b1[uu];
                _Pragma("unroll 11") for (int f = 0; f < 33; ++f) sacc += zf[pi * 33 + f] * w1[f * 64 + uu];
                hA[pi * 64 + uu] = sinf(fq[uu] * sacc); }
            __syncthreads();
#pragma unroll
            for (int h2 = 0; h2 < 2; ++h2) { const int e = tid + 512 * h2, pi = e >> 6, uu = e & 63; float sacc = bi[uu];
                _Pragma("unroll 16") for (int k = 0; k < 64; ++k) sacc += hA[pi * 64 + k] * wi[k * 64 + uu];
                hB[pi * 64 + uu] = sinf(fq[uu] * sacc); }
            __syncthreads();
#pragma unroll
            for (int h2 = 0; h2 < 2; ++h2) { const int e = tid + 512 * h2, pi = e >> 6, uu = e & 63; float sacc = bi[64 + uu];
                _Pragma("unroll 16") for (int k = 0; k < 64; ++k) sacc += hB[pi * 64 + k] * wi[4096 + k * 64 + uu];
                hA[pi * 64 + uu] = sinf(fq[uu] * sacc); }
            __syncthreads();
#pragma unroll 1
            for (int cc = 0; cc < 2; ++cc) { const int c = tid + 512 * cc; float a[16];
#pragma unroll
                for (int pi = 0; pi < 16; ++pi) a[pi] = 0.f;
                _Pragma("unroll 2") for (int k4 = 0; k4 < 16; ++k4) {
                    const float w0 = wo[(4 * k4 + 0) * HW + c], w1 = wo[(4 * k4 + 1) * HW + c], w2 = wo[(4 * k4 + 2) * HW + c], w3 = wo[(4 * k4 + 3) * HW + c];
#pragma unroll
                    for (int pi = 0; pi < 16; ++pi) { const f32x4 hv = *(const LAS f32x4*)(hA + pi * 64 + 4 * k4); a[pi] += (hv[0] * w0 + hv[1] * w1) + (hv[2] * w2 + hv[3] * w3); } }
                const float ad = fabsf(dec[c]);
#pragma unroll
                for (int pi = 0; pi < 16; ++pi) { const int p = FPOS(pi); const int ao = p >= 2048 ? p - 2048 : 2048 - p; const float offs = (float)ao * (1.0f / 2048.0f);
                    float v = a[pi] * expf(-offs * ad); if (p == 2048) v += hb[c]; a[pi] = v; }
                bf16_t* row = hr + (size_t)c * HRLEN;
                if (!edge) { u32x4* d = (u32x4*)(row + 16 * (133 + r));
                    d[0] = (u32x4){cvt_pk_bf16(a[0], a[1]), cvt_pk_bf16(a[2], a[3]), cvt_pk_bf16(a[4], a[5]), cvt_pk_bf16(a[6], a[7])};
                    d[1] = (u32x4){cvt_pk_bf16(a[8], a[9]), cvt_pk_bf16(a[10], a[11]), cvt_pk_bf16(a[12], a[13]), cvt_pk_bf16(a[14], a[15])}; }
                else { u32x4* dA = (u32x4*)(row + 2112); u32x4* dB = (u32x4*)(row + 6208);
                    dA[0] = (u32x4){cvt_pk_bf16(0.f, a[0]), cvt_pk_bf16(a[1], a[2]), cvt_pk_bf16(a[3], a[4]), cvt_pk_bf16(a[5], a[6])};
                    dA[1] = (u32x4){cvt_pk_bf16(a[7], a[8]), cvt_pk_bf16(a[9], a[10]), cvt_pk_bf16(a[11], a[12]), cvt_pk_bf16(a[13], a[14])};
                    dB[0] = (u32x4){cvt_pk_bf16(a[15], 0.f), 0u, 0u, 0u}; dB[1] = (u32x4){0u, 0u, 0u, 0u}; } }
            __syncthreads();
#undef FPOS
        }
    }
}

constexpr int KPITCH = 272, VPITCH = 288, AT_VS = 256 * KPITCH, AT_BT = AT_VS + 272 * VPITCH;
constexpr int ATT_ITEMS = 6144;
__device__ __forceinline__ void att_decode(int item, int& g, int& b, int& h, int& r, int& n0, int& dsh) {
    g = item >> 11; const int rem = item & 2047, bh = rem >> 5, sub = rem & 31; b = bh >> 3; h = bh & 7;
    dsh = g == 0 ? 0 : (g == 1 ? 2 : 4); const int psh = g == 0 ? 5 : (g == 1 ? 3 : 1);
    r = sub >> psh; n0 = 2 * (sub & ((1 << psh) - 1));
}
__device__ __forceinline__ void att_issue(const unsigned char* ws, int item, int tid, int wave, int lane, u32x4 (&pre)[16], bf16x8 (&qpre)[4], float& bpre, unsigned& vmask) {
    int g, b, h, r, n0, dsh; att_decode(item, g, b, h, r, n0, dsh);
    const int Ls = SEQ >> dsh, tokbase = b * SEQ;
    const bf16_t* Qp = (const bf16_t*)(ws + WS_Q); const bf16_t* Kp = (const bf16_t*)(ws + WS_K); const bf16_t* Vp = (const bf16_t*)(ws + WS_V);
    unsigned vm = 0u;
#pragma unroll
    for (int i = 0; i < 16; ++i) { const int c2 = (tid + 512 * i) & 4095, ki = c2 >> 4, cc = c2 & 15, idx = 64 * (n0 - 1) + ki;
        const bool ok = idx >= 0 && idx < Ls; const int pos = ((ok ? idx : 0) << dsh) + r;
        pre[i] = *(const u32x4*)((i < 8 ? Kp : Vp) + (size_t)(tokbase + pos) * AW + h * 128 + cc * 8);
        vm |= (ok ? 1u : 0u) << i; }
    vmask = vm;
    { const int qb = wave >> 2, t = wave & 3, idxq = 64 * (n0 + qb) + 16 * t + (lane & 15); const int tokq = tokbase + (idxq << dsh) + r;
        const bf16_t* qp = Qp + (size_t)tokq * AW + h * 128 + 8 * (lane >> 4);
#pragma unroll
        for (int kk = 0; kk < 4; ++kk) qpre[kk] = *(const bf16x8*)(qp + 32 * kk); }
    { const int bi = tid - 15; bpre = ((const float*)(ws + WS_BTAB))[(g * 8 + h) * 129 + (bi < 0 ? 0 : (bi > 128 ? 128 : bi))]; }
}
__device__ __forceinline__ void att_body(unsigned char* ws, LAS unsigned char* ks, LAS unsigned char* vs, LAS float* btab, int item, int nxt, int tid, int wave, int lane,
                                         u32x4 (&pre)[16], bf16x8 (&qpre)[4], float& bpre, unsigned& vmask) {
#pragma unroll
        for (int i = 0; i < 16; ++i) { const int c2 = (tid + 512 * i) & 4095, ki = c2 >> 4, cc = c2 & 15;
            u32x4 v = pre[i]; if (!((vmask >> i) & 1u)) v = (u32x4){0u, 0u, 0u, 0u};
            if (i < 8) *(LAS u32x4*)(ks + ki * KPITCH + cc * 16) = v; else *(LAS u32x4*)(vs + ki * VPITCH + cc * 16) = v; }
        if (tid < 160) btab[tid] = (tid >= 15 && tid <= 143) ? bpre : -1.0e30f;
        bf16x8 qf[4];
#pragma unroll
        for (int kk = 0; kk < 4; ++kk) qf[kk] = qpre[kk];
        asm volatile("s_waitcnt lgkmcnt(0)" ::: "memory"); __builtin_amdgcn_s_barrier(); asm volatile("" ::: "memory");
        att_issue(ws, nxt, tid, wave, lane, pre, qpre, bpre, vmask);
        {
            int g, b, h, r, n0, dsh; att_decode(item, g, b, h, r, n0, dsh);
            const int Ls = SEQ >> dsh, tokbase = b * SEQ;
            const int qb = wave >> 2, t = wave & 3, n = n0 + qb, l15 = lane & 15, rg = lane >> 4;
            const int tokq = tokbase + ((64 * n + 16 * t + l15) << dsh) + r;
            f32x4 S[9];
            const LAS unsigned char* kb = ks + (64 * qb + 16 * t + l15) * KPITCH + 16 * rg;
            bf16x8 kfa[9], kfb[9];
#pragma unroll
            for (int kt = 0; kt < 9; ++kt) { S[kt] = (f32x4){0.f, 0.f, 0.f, 0.f}; kfa[kt] = *(const LAS bf16x8*)(kb + (16 * kt) * KPITCH); }
#pragma unroll
            for (int kk = 0; kk < 4; ++kk) {
                if (kk < 3) {
#pragma unroll
                    for (int kt = 0; kt < 9; ++kt) { if (kk & 1) kfa[kt] = *(const LAS bf16x8*)(kb + (16 * kt) * KPITCH + 64 * (kk + 1)); else kfb[kt] = *(const LAS bf16x8*)(kb + (16 * kt) * KPITCH + 64 * (kk + 1)); } }
#pragma unroll
                for (int kt = 0; kt < 9; ++kt) S[kt] = __builtin_amdgcn_mfma_f32_16x16x32_bf16((kk & 1) ? kfb[kt] : kfa[kt], qf[kk], S[kt], 0, 0, 0);
            }
            float mx = -3.0e38f;
            const int idxk0 = 64 * (n - 1) + 16 * t + 4 * rg;
            const LAS float* tb = btab + (4 * rg - l15 + 15);
#pragma unroll
            for (int kt = 0; kt < 9; ++kt)
#pragma unroll
                for (int j = 0; j < 4; ++j) { const int idxk = idxk0 + 16 * kt + j;
                    const float pen = (idxk >= 0 && idxk < Ls) ? 0.f : -1.0e30f;
                    const float sv = fmaxf((S[kt][j] + tb[16 * kt + j]) + pen, -1.0e30f);
                    S[kt][j] = sv; mx = fmaxf(mx, sv); }
            mx = fmaxf(mx, __shfl_xor(mx, 16)); mx = fmaxf(mx, __shfl_xor(mx, 32));
            float lsum = 0.f; bf16x8 pf[5];
#pragma unroll
            for (int ksx = 0; ksx < 5; ++ksx) { float e[8];
#pragma unroll
                for (int j = 0; j < 4; ++j) { e[j] = __expf(S[2 * ksx][j] - mx); e[4 + j] = (2 * ksx + 1 < 9) ? __expf(S[(2 * ksx + 1 < 9) ? 2 * ksx + 1 : 8][j] - mx) : 0.f; }
#pragma unroll
                for (int j = 0; j < 8; ++j) lsum += e[j];
                u32x4 w; w.x = cvt_pk_bf16(e[0], e[1]); w.y = cvt_pk_bf16(e[2], e[3]); w.z = cvt_pk_bf16(e[4], e[5]); w.w = cvt_pk_bf16(e[6], e[7]);
                pf[ksx] = __builtin_bit_cast(bf16x8, w); }
            lsum += __shfl_xor(lsum, 16); lsum += __shfl_xor(lsum, 32);
            f32x4 O[8];
#pragma unroll
            for (int ct = 0; ct < 8; ++ct) O[ct] = (f32x4){0.f, 0.f, 0.f, 0.f};
            const LAS unsigned char* vb = vs + (64 * qb + 16 * t + 4 * rg + (l15 >> 2)) * VPITCH + 64 * (lane & 3);
#pragma unroll
            for (int ksx = 0; ksx < 5; ++ksx)
#pragma unroll
                for (int ct = 0; ct < 8; ++ct) {
                    const s16x4 lo = __builtin_amdgcn_ds_read_tr16_b64_v4i16((LAS s16x4*)(vb + (32 * ksx) * VPITCH + 8 * ct));
                    const s16x4 hi = __builtin_amdgcn_ds_read_tr16_b64_v4i16((LAS s16x4*)(vb + (32 * ksx + 16) * VPITCH + 8 * ct));
                    const bf16x8 vf = __builtin_shufflevector(lo, hi, 0, 1, 2, 3, 4, 5, 6, 7);
                    O[ct] = __builtin_amdgcn_mfma_f32_16x16x32_bf16(vf, pf[ksx], O[ct], 0, 0, 0); }
            bf16_t* op = (bf16_t*)(ws + WS_OG) + ((size_t)g * MTOK + tokq) * AW + h * 128 + 32 * rg; const float inv = 1.0f / lsum;
#pragma unroll
            for (int c2 = 0; c2 < 4; ++c2) { const f32x4 o0 = O[2 * c2] * inv, o1 = O[2 * c2 + 1] * inv;
                u32x4 w; w.x = cvt_pk_bf16(o0[0], o0[1]); w.y = cvt_pk_bf16(o0[2], o0[3]); w.z = cvt_pk_bf16(o1[0], o1[1]); w.w = cvt_pk_bf16(o1[2], o1[3]); *(u32x4*)(op + 8 * c2) = w; }
            ((float*)(ws + WS_LSE))[((size_t)g * MTOK + tokq) * 8 + h] = mx + __logf(lsum);
        }
        asm volatile("s_waitcnt lgkmcnt(0)" ::: "memory"); __builtin_amdgcn_s_barrier(); asm volatile("" ::: "memory");
}
__device__ __forceinline__ void attn_phase(const Args& A, LAS unsigned char* lds) {
    const int tid = threadIdx.x, lane = tid & 63, wave = __builtin_amdgcn_readfirstlane(tid >> 6), G = gridDim.x;
    unsigned char* ws = A.ws;
    LAS unsigned char* ks = lds; LAS unsigned char* vs = lds + AT_VS; LAS float* btab = (LAS float*)(lds + AT_BT);
    if (tid < 288) *(LAS u32x4*)(vs + 256 * VPITCH + tid * 16) = (u32x4){0u, 0u, 0u, 0u};
    u32x4 pre[16]; bf16x8 qpre[4]; float bpre; unsigned vmask;
    const bool xmap = (G == 256);
    const int per = xmap ? 24 : (ATT_ITEMS + G - 1) / G;
    const int ibase = blockIdx.x * per, nit = xmap ? 24 : ((ibase + per) < ATT_ITEMS ? per : (ATT_ITEMS - ibase > 0 ? ATT_ITEMS - ibase : 0));
#define ATT_MAP(i) (xmap ? (((((3 * (int)(blockIdx.x >> 3) + (i) % 3) >> 5) << 11) | (((int)(blockIdx.x & 7) + 8 * ((i) / 3)) << 5) | ((3 * (int)(blockIdx.x >> 3) + (i) % 3) & 31))) : (ibase + (i)))
    if (nit > 0) {
        int item = ATT_MAP(0);
        att_issue(ws, item, tid, wave, lane, pre, qpre, bpre, vmask);
        { const int nxt = ATT_MAP(1 < nit ? 1 : 0); att_body(ws, ks, vs, btab, item, nxt, tid, wave, lane, pre, qpre, bpre, vmask); item = nxt; }
        for (int ii = 1; ii < nit; ++ii) { const int nxt = ATT_MAP(ii + 1 < nit ? ii + 1 : ii); att_body(ws, ks, vs, btab, item, nxt, tid, wave, lane, pre, qpre, bpre, vmask); item = nxt; }
    }
#undef ATT_MAP
    __syncthreads();
}

__device__ __forceinline__ float bf_el(u32x2 r, int ch) { return ch == 0 ? bf_lo(r.x) : (ch == 1 ? bf_hi(r.x) : (ch == 2 ? bf_lo(r.y) : bf_hi(r.y))); }
__device__ __forceinline__ void sconv_phase(const Args& A) {
    const int tid = threadIdx.x, lane = tid & 63, wave = tid >> 6, gw = blockIdx.x * 8 + wave, NGW = gridDim.x * 8; unsigned char* ws = A.ws;
    const bf16_t* HY = (const bf16_t*)(ws + WS_HY); const float* cw = A.in[7]; const float* cb = A.in[8];
    bf16_t* zt = (bf16_t*)(ws + WS_ZT); bf16_t* x0t = (bf16_t*)(ws + WS_X0T);
    const int b = lane >> 3, cgp = lane & 7;
    const bool xmap = (gridDim.x == 256);
    const int wid = (int)(blockIdx.x >> 3) * 8 + wave;
    for (int it = 0; it < (xmap ? 8 : (32 * 512 + NGW - 1) / NGW); ++it) {
        const int id = xmap ? ((8 * ((int)(blockIdx.x & 7) + 8 * it) + (wid >> 5)) * 32 + (wid & 31)) : (gw + NGW * it);
        if (id >= 32 * 512) break;
        const int ct = id & 31, q = id >> 5, c0 = 32 * ct + 4 * cgp, j0 = 8 * q;
        f32x4 w[3][3], bs[3];
#pragma unroll
        for (int s = 0; s < 3; ++s) { bs[s] = *(const f32x4*)(cb + s * 1024 + c0);
#pragma unroll
            for (int t = 0; t < 3; ++t) w[s][t] = *(const f32x4*)(cw + t * 3072 + s * 1024 + c0); }
        u32x2 rows[10][3];
#pragma unroll
        for (int rr = 0; rr < 10; ++rr) { const int js = j0 - 1 + rr; const bool ok = js >= 0 && js < SEQ; const bf16_t* rp = HY + (size_t)(b * SEQ + (ok ? js : 0)) * 3072 + c0;
#pragma unroll
            for (int s = 0; s < 3; ++s) { u32x2 v = *(const u32x2*)(rp + s * 1024); if (!ok) v = (u32x2){0u, 0u}; rows[rr][s] = v; } }
        unsigned ox[4][4], oz[4][4]; float px[4], pz[4];
#pragma unroll
        for (int jj = 0; jj < 8; ++jj) {
#pragma unroll
            for (int ch = 0; ch < 4; ++ch) { float v[3];
#pragma unroll
                for (int s = 0; s < 3; ++s) v[s] = bs[s][ch] + w[s][0][ch] * bf_el(rows[jj][s], ch) + w[s][1][ch] * bf_el(rows[jj + 1][s], ch) + w[s][2][ch] * bf_el(rows[jj + 2][s], ch);
                const float x0 = v[0], z = v[2] * v[1];
                if (jj & 1) { ox[ch][jj >> 1] = cvt_pk_bf16(px[ch], x0); oz[ch][jj >> 1] = cvt_pk_bf16(pz[ch], z); } else { px[ch] = x0; pz[ch] = z; } } }
#pragma unroll
        for (int ch = 0; ch < 4; ++ch) { const size_t dst = ((size_t)(c0 + ch) * 512 + q) * 64 + b * 8;
            *(u32x4*)(x0t + dst) = (u32x4){ox[ch][0], ox[ch][1], ox[ch][2], ox[ch][3]}; *(u32x4*)(zt + dst) = (u32x4){oz[ch][0], oz[ch][1], oz[ch][2], oz[ch][3]}; }
    }
}

__device__ __forceinline__ void lconv_item(const Args& A, LAS unsigned char* lds, int c) {
    const int tid = threadIdx.x, lane = tid & 63, wave = __builtin_amdgcn_readfirstlane(tid >> 6); unsigned char* ws = A.ws;
    LAS unsigned char* zs = lds; LAS unsigned char* hA = lds + 70144; LAS unsigned char* hB = hA + 16640;
    { const u32x4* zsrc = (const u32x4*)((const bf16_t*)(ws + WS_ZT) + (size_t)c * 32768);
        for (int ch = tid; ch < 4096; ch += 512) *(LAS u32x4*)(zs + 256 + ch * 16) = zsrc[ch];
        if (tid < 16) *(LAS u32x4*)(zs + tid * 16) = (u32x4){0u, 0u, 0u, 0u};
        if (tid >= 64 && tid < 336) *(LAS u32x4*)(zs + 65792 + (tid - 64) * 16) = (u32x4){0u, 0u, 0u, 0u};
        const u32x4* hsrc = (const u32x4*)((const bf16_t*)(ws + WS_HR) + (size_t)c * HRLEN);
        for (int ch = tid; ch < 1040; ch += 512) *(LAS u32x4*)(hA + ch * 16) = hsrc[ch]; }
    __syncthreads();
    for (int k = tid; k < 4160; k += 512) { const unsigned lo = ((const LAS unsigned*)hA)[k], hi = (k + 1 < 4160) ? ((const LAS unsigned*)hA)[k + 1] : 0u; ((LAS unsigned*)hB)[k] = (lo >> 16) | (hi << 16); }
    __syncthreads();
    {
        const int m = lane & 15, gq = lane >> 4;
        const LAS unsigned char* tbase = ((m & 1) ? (hB - 2) : hA) + 2 * (4144 + 8 * gq - m);
        const int bb = m & 7, sh = m >> 3;
        const LAS unsigned char* zbase = zs + ((2 * sh + gq) * 8 + bb) * 16;
        const bf16_t* x0t = (const bf16_t*)(ws + WS_X0T) + (size_t)c * 32768; bf16_t* yt = (bf16_t*)(ws + WS_YT) + (size_t)c * 32768;
#pragma unroll 1
        for (int ib = 0; ib < 2; ++ib) {
            const int It0 = 16 * wave + 8 * ib;
            const int jlo = (It0 - 64) > 0 ? (It0 - 64) : 0, jhi = (It0 + 71) < 128 ? (It0 + 71) : 128;
            const int elo = jlo - It0, nch = (jhi - jlo + 8) >> 3;
            const LAS unsigned char* tp = tbase + 64 * elo; const LAS unsigned char* zp = zbase + 512 * jlo;
            f32x4 acc[8]; bf16x8 R[8];
#pragma unroll
            for (int p = 0; p < 8; ++p) acc[p] = (f32x4){0.f, 0.f, 0.f, 0.f};
            R[0] = (bf16x8){0, 0, 0, 0, 0, 0, 0, 0};
#pragma unroll
            for (int k = 1; k < 8; ++k) R[k] = __builtin_bit_cast(bf16x8, *(const LAS u32x4_a4*)(tp + 64 * (k - 8)));
#pragma unroll 1
            for (int chn = 0; chn < nch; ++chn) {
#pragma unroll
                for (int k = 0; k < 8; ++k) {
                    R[k] = __builtin_bit_cast(bf16x8, *(const LAS u32x4_a4*)(tp + 64 * k));
                    const bf16x8 zf = *(const LAS bf16x8*)(zp + 512 * k);
#pragma unroll
                    for (int p = 0; p < 8; ++p) acc[p] = __builtin_amdgcn_mfma_f32_16x16x32_bf16(R[(k - p) & 7], zf, acc[p], 0, 0, 0); }
                tp += 512; zp += 4096; }
#pragma unroll
            for (int p = 0; p < 8; ++p) { const int q = 4 * (It0 + p) + 2 * sh + (gq >> 1); const size_t off = (size_t)(q * 8 + bb) * 8 + 4 * (gq & 1);
                const u32x2 xw = *(const u32x2*)(x0t + off);
                u32x2 w; w.x = cvt_pk_bf16(acc[p][0] * bf_lo(xw.x), acc[p][1] * bf_hi(xw.x)); w.y = cvt_pk_bf16(acc[p][2] * bf_lo(xw.y), acc[p][3] * bf_hi(xw.y));
                *(u32x2*)(yt + off) = w; }
        }
    }
    __syncthreads();
}

__device__ __forceinline__ void merge_attn(const Args& A) {
    const int tid = threadIdx.x, lane = tid & 63, wave = tid >> 6, gw = blockIdx.x * 8 + wave, NGW = gridDim.x * 8; unsigned char* ws = A.ws;
    const bf16_t* og = (const bf16_t*)(ws + WS_OG); const float* lse = (const float*)(ws + WS_LSE); bf16_t* y = (bf16_t*)(ws + WS_Y); const float* gain = A.in[17];
    const int head = lane >> 3, col = lane * 16;
    f32x4 gn[4];
#pragma unroll
    for (int k = 0; k < 4; ++k) gn[k] = *(const f32x4*)(gain + col + 4 * k);
    for (int tok = gw; tok < MTOK; tok += NGW) {
        float l[3], mxl = -3.0e38f;
#pragma unroll
        for (int g = 0; g < 3; ++g) { l[g] = lse[((size_t)g * MTOK + tok) * 8 + head]; mxl = fmaxf(mxl, l[g]); }
        float wsum = 0.f;
#pragma unroll
        for (int g = 0; g < 3; ++g) { l[g] = __expf(l[g] - mxl); wsum += l[g]; }
        const float iw = 1.0f / wsum; float v[16];
#pragma unroll
        for (int k = 0; k < 16; ++k) v[k] = 0.f;
#pragma unroll
        for (int g = 0; g < 3; ++g) { const float wg = l[g] * iw; const u32x4* src = (const u32x4*)(og + ((size_t)g * MTOK + tok) * AW + col);
#pragma unroll
            for (int k = 0; k < 2; ++k) { const u32x4 t = src[k];
                v[8 * k + 0] += wg * bf_lo(t.x); v[8 * k + 1] += wg * bf_hi(t.x); v[8 * k + 2] += wg * bf_lo(t.y); v[8 * k + 3] += wg * bf_hi(t.y);
                v[8 * k + 4] += wg * bf_lo(t.z); v[8 * k + 5] += wg * bf_hi(t.z); v[8 * k + 6] += wg * bf_lo(t.w); v[8 * k + 7] += wg * bf_hi(t.w); } }
        float ss = 0.f;
#pragma unroll
        for (int k = 0; k < 16; ++k) ss += v[k] * v[k];
        ss += __shfl_xor(ss, 1); ss += __shfl_xor(ss, 2); ss += __shfl_xor(ss, 4);
        const float r = 1.0f / sqrtf(ss * (1.0f / 128.0f) + EPS);
        u32x4 o0, o1;
        o0.x = cvt_pk_bf16(v[0] * r * gn[0][0], v[1] * r * gn[0][1]); o0.y = cvt_pk_bf16(v[2] * r * gn[0][2], v[3] * r * gn[0][3]);
        o0.z = cvt_pk_bf16(v[4] * r * gn[1][0], v[5] * r * gn[1][1]); o0.w = cvt_pk_bf16(v[6] * r * gn[1][2], v[7] * r * gn[1][3]);
        o1.x = cvt_pk_bf16(v[8] * r * gn[2][0], v[9] * r * gn[2][1]); o1.y = cvt_pk_bf16(v[10] * r * gn[2][2], v[11] * r * gn[2][3]);
        o1.z = cvt_pk_bf16(v[12] * r * gn[3][0], v[13] * r * gn[3][1]); o1.w = cvt_pk_bf16(v[14] * r * gn[3][2], v[15] * r * gn[3][3]);
        u32x4* dst = (u32x4*)(y + (size_t)tok * DM + col); dst[0] = o0; dst[1] = o1;
    }
}
__device__ __forceinline__ void hynorm_item(const Args& A, LAS unsigned char* lds, int item) {
    const int tid = threadIdx.x; unsigned char* ws = A.ws;
    const int grp = item >> 9, q = item & 511;
    LAS float* t = (LAS float*)lds;
    { const int c = tid >> 2, part = tid & 3; const u32x4* src = (const u32x4*)((const bf16_t*)(ws + WS_YT) + ((size_t)(grp * 128 + c) * 512 + q) * 64 + part * 16);
#pragma unroll
        for (int k = 0; k < 2; ++k) { const u32x4 v = src[k]; LAS float* d = t + c * 65 + part * 16 + 8 * k;
            d[0] = bf_lo(v.x); d[1] = bf_hi(v.x); d[2] = bf_lo(v.y); d[3] = bf_hi(v.y); d[4] = bf_lo(v.z); d[5] = bf_hi(v.z); d[6] = bf_lo(v.w); d[7] = bf_hi(v.w); } }
    __syncthreads();
    { const int pos = tid >> 3, p8 = tid & 7; float v[16], ss = 0.f;
#pragma unroll
        for (int k = 0; k < 16; ++k) { v[k] = t[(p8 * 16 + k) * 65 + pos]; ss += v[k] * v[k]; }
        ss += __shfl_xor(ss, 1); ss += __shfl_xor(ss, 2); ss += __shfl_xor(ss, 4);
        const float r = 1.0f / sqrtf(ss * (1.0f / 128.0f) + EPS); const float* gp = A.in[18] + grp * 128 + p8 * 16;
        unsigned w[8];
#pragma unroll
        for (int k = 0; k < 8; ++k) w[k] = cvt_pk_bf16(v[2 * k] * r * gp[2 * k], v[2 * k + 1] * r * gp[2 * k + 1]);
        const int b = pos >> 3, i8 = pos & 7; bf16_t* dst = (bf16_t*)(ws + WS_Y) + (size_t)(b * SEQ + 8 * q + i8) * DM + 1024 + grp * 128 + p8 * 16;
        ((u32x4*)dst)[0] = (u32x4){w[0], w[1], w[2], w[3]}; ((u32x4*)dst)[1] = (u32x4){w[4], w[5], w[6], w[7]}; }
    __syncthreads();
}

#define XB_TMO      128
#define XB_XCNT(j)  (256  + 64 * (j))
#define XB_XSUB(j)  (1280 + 64 * (j))
#define XB_XGEN(j)  (2304 + 64 * (j))
#define XB_TOP      3328
#define XB_TOPGEN   3392
#define XCD_BAR_WORDS 3456
#define XB_SPIN_CAP (1u << 18)
__device__ __forceinline__ unsigned xb_ld(unsigned* p)              { return __hip_atomic_load(p, __ATOMIC_RELAXED, __HIP_MEMORY_SCOPE_AGENT); }
__device__ __forceinline__ unsigned xb_add(unsigned* p, unsigned v) { return __hip_atomic_fetch_add(p, v, __ATOMIC_RELAXED, __HIP_MEMORY_SCOPE_AGENT); }
__device__ __forceinline__ unsigned xb_xcc_id() { return (unsigned)__builtin_amdgcn_s_getreg((3 << 11) | 20) & 0xFu; }
#define XB_SPIN(cond, bar) do { unsigned _sp = 0; while (cond) { __builtin_amdgcn_s_sleep(1); \
    if ((++_sp & 255u) == 0u) { if (xb_ld(&(bar)[XB_TMO])) break; if (_sp > XB_SPIN_CAP) { atomicAdd(&(bar)[XB_TMO], 1u); break; } } } } while (0)
struct XcdBarrier { unsigned* bar; unsigned x; volatile LAS unsigned* st; };
__device__ __forceinline__ XcdBarrier xcd_barrier_post(unsigned* bar, volatile LAS unsigned* st) {
    XcdBarrier b; b.bar = bar; b.x = xb_xcc_id(); b.st = st;
    if (threadIdx.x == 0) (void)xb_add(&bar[XB_XCNT(b.x)], 1u);
    return b;
}
__device__ __forceinline__ void xcd_barrier_complete(unsigned* bar, unsigned x, unsigned& nloc, unsigned& nx) {
    const unsigned G = gridDim.x * gridDim.y * gridDim.z;
    unsigned sum, cnt, mine, sp = 0u;
    for (;;) {
        sum = 0u; cnt = 0u; mine = 0u;
#pragma unroll
        for (unsigned j = 0; j < 16; ++j) { const unsigned c = xb_ld(&bar[XB_XCNT(j)]); sum += c; cnt += (c > 0u) ? 1u : 0u; mine = (j == x) ? c : mine; }
        if (sum == G) break;
        __builtin_amdgcn_s_sleep(1);
        if ((++sp & 255u) == 0u) { if (xb_ld(&bar[XB_TMO])) break; if (sp > XB_SPIN_CAP) { atomicAdd(&bar[XB_TMO], 1u); break; } }
    }
    nloc = mine > 0u ? mine : 1u; nx = cnt > 0u ? cnt : 1u;
}
__device__ __forceinline__ void xcd_barrier(const XcdBarrier& b) {
    asm volatile("s_waitcnt vmcnt(0)" ::: "memory");
    __syncthreads();
    if (threadIdx.x == 0) {
        unsigned* bar = b.bar;
        __builtin_amdgcn_s_waitcnt(0);
        unsigned nloc = b.st[0], nx = b.st[1];
        if (nloc == 0u) { xcd_barrier_complete(bar, b.x, nloc, nx); b.st[0] = nloc; b.st[1] = nx; }
        const unsigned old = xb_add(&bar[XB_XSUB(b.x)], 1u);
        const unsigned gen = old / nloc;
        if (old + 1u == (gen + 1u) * nloc) {
            __builtin_amdgcn_fence(__ATOMIC_RELEASE, "agent");
            asm volatile("s_waitcnt vmcnt(0)" ::: "memory");
            const unsigned og = xb_add(&bar[XB_TOP], 1u);
            const unsigned tg = og / nx;
            if (og + 1u == (tg + 1u) * nx) xb_add(&bar[XB_TOPGEN], 1u);
            else XB_SPIN(xb_ld(&bar[XB_TOPGEN]) == tg, bar);
            __builtin_amdgcn_fence(__ATOMIC_ACQUIRE, "agent");
            xb_add(&bar[XB_XGEN(b.x)], 1u);
            asm volatile("s_waitcnt vmcnt(0)" ::: "memory");
        } else {
            XB_SPIN(xb_ld(&bar[XB_XGEN(b.x)]) == gen, bar);
            __builtin_amdgcn_fence(__ATOMIC_ACQUIRE, "agent");
            asm volatile("s_waitcnt vmcnt(0)" ::: "memory");
        }
    }
    __syncthreads();
}

__global__ void __launch_bounds__(512, 2) fwd_mega(Args args) {
    extern __shared__ __attribute__((aligned(16))) unsigned char lds_raw[];
    LAS unsigned char* lds = (LAS unsigned char*)lds_raw;
    LAS float* xl = (LAS float*)(lds + XL_OFF);
    const int lo = args.ph_lo, hi = args.ph_hi, G = gridDim.x;
    unsigned char* ws = args.ws;
    volatile LAS unsigned* bst = (volatile LAS unsigned*)(lds + BARST_OFF);
    if (threadIdx.x < 2) bst[threadIdx.x] = 0u;
    __syncthreads();
    const XcdBarrier xbar = xcd_barrier_post((unsigned*)(ws + WS_BAR), bst);
#ifndef DUPMASK
#define DUPMASK 0
#endif
#define IN(k) (lo <= (k) && (k) < hi)
#define REP(k) for (int rep_ = 0; rep_ < (((DUPMASK >> (k)) & 1) ? 2 : 1); ++rep_, (rep_ < 2 && ((DUPMASK >> (k)) & 1)) ? cg::this_grid().sync() : (void)0)
#define SEAM(k) do { if (IN(k) && IN((k) + 1)) { if ((k) == 0) cg::this_grid().sync(); else xcd_barrier(xbar); } } while (0)
    if (IN(0)) REP(0) { p0_prologue(args, lds); } SEAM(0);
    if (IN(1)) { pg8::Gemm g{(const bf16_t*)(ws + WS_XB), (const bf16_t*)(ws + WS_WIN), MTOK, INW, DM}; pg8::StaticOrder S; S.init(MTOK, INW, G, (int)blockIdx.x);
        EpiIn E{ws, args.in[5], args.in[6]}; pg8::gemm_phase(lds, xl, g, S, E); } SEAM(1);
    if (IN(2)) REP(2) { attn_phase(args, lds);
        sconv_phase(args); } SEAM(2);
    if (IN(3)) REP(3) { for (int c = blockIdx.x; c < HW; c += G) lconv_item(args, lds, c); } SEAM(3);
    if (IN(4)) REP(4) { merge_attn(args); for (int it = blockIdx.x; it < 4096; it += G) hynorm_item(args, lds, it); } SEAM(4);
    if (IN(5)) { { pg8::Gemm g{(const bf16_t*)(ws + WS_Y), (const bf16_t*)(ws + WS_WOUT), MTOK, DM, DM}; pg8::StaticOrder S; S.init(MTOK, DM, G, (int)blockIdx.x);
            EpiOut E{args.in[0], (bf16_t*)(ws + WS_H1B), (float*)(ws + WS_SS1)}; pg8::gemm_phase(lds, xl, g, S, E); }
        { pg8::Gemm g{(const bf16_t*)(ws + WS_PB), (const bf16_t*)(ws + WS_WPROJ), MTOK, DM, PLE}; pg8::StaticOrder S; S.init(MTOK, DM, G, (int)blockIdx.x);
            EpiProj E{(bf16_t*)(ws + WS_ERAW), (float*)(ws + WS_SSE)}; pg8::gemm_phase(lds, xl, g, S, E); } } SEAM(5);
    if (IN(6)) { pg8::Gemm g{(const bf16_t*)(ws + WS_H1B), (const bf16_t*)(ws + WS_WGU), MTOK, 2 * FF, DM}; pg8::StaticOrder S; S.init(MTOK, 2 * FF, G, (int)blockIdx.x);
        EpiGU E{(bf16_t*)(ws + WS_ACT), (const float*)(ws + WS_SS1)}; pg8::gemm_phase(lds, xl, g, S, E); } SEAM(6);
    if (IN(7)) { pg8::Gemm g{(const bf16_t*)(ws + WS_ACT), (const bf16_t*)(ws + WS_WDOWN), MTOK, DM, FF}; pg8::StaticOrder S; S.init(MTOK, DM, G, (int)blockIdx.x);
        EpiDown E{(const bf16_t*)(ws + WS_H1B), (bf16_t*)(ws + WS_H2B), (float*)(ws + WS_SS2)}; pg8::gemm_phase(lds, xl, g, S, E); } SEAM(7);
    if (IN(8)) { pg8::Gemm g{(const bf16_t*)(ws + WS_H2B), (const bf16_t*)(ws + WS_WGATE), MTOK, DM, DM}; pg8::StaticOrder S; S.init(MTOK, DM, G, (int)blockIdx.x);
        EpiGate E{args.out, (const bf16_t*)(ws + WS_H2B), (const bf16_t*)(ws + WS_ERAW), (const float*)(ws + WS_SS2), (const float*)(ws + WS_SSE), args.in[26]}; pg8::gemm_phase(lds, xl, g, S, E); }
#undef IN
#undef SEAM
}

extern "C" void kernel_launch(void* const* d_in, const int* in_sizes, int n_in, void* d_out, int out_size, void* d_ws, size_t ws_size, hipStream_t stream) {
    static int grid = 0;
    if (grid == 0) {
        if (n_in != 27 || out_size != MTOK * DM || ws_size < WS_END) { fprintf(stderr, "kernel_launch: unexpected shapes (n_in %d out %d ws %zu)\n", n_in, out_size, ws_size); grid = -1; return; }
        int dev = 0, cus = 0, per_cu = 0;
        (void)hipGetDevice(&dev); (void)hipDeviceGetAttribute(&cus, hipDeviceAttributeMultiprocessorCount, dev);
        if (hipFuncSetAttribute((const void*)fwd_mega, hipFuncAttributeMaxDynamicSharedMemorySize, LDS_BYTES) != hipSuccess) { fprintf(stderr, "kernel_launch: hipFuncSetAttribute failed\n"); grid = -1; return; }
        if (hipOccupancyMaxActiveBlocksPerMultiprocessor(&per_cu, (const void*)fwd_mega, 512, LDS_BYTES) != hipSuccess || per_cu < 1) { fprintf(stderr, "kernel_launch: occupancy query says %d\n", per_cu); per_cu = 1; }
        (void)hipGetLastError();
        grid = cus * per_cu;
    }
    if (grid < 0) return;
    Args a{};
    for (int i = 0; i < 27; ++i) a.in[i] = (const float*)d_in[i];
    a.out = (float*)d_out; a.ws = (unsigned char*)d_ws;
#if ONE_LAUNCH
    (void)hipMemsetAsync((unsigned char*)d_ws + WS_BAR, 0, XCD_BAR_WORDS * 4, stream);
    a.ph_lo = 0; a.ph_hi = NPH;
    void* kargs[] = {&a};
    hipError_t e = hipLaunchCooperativeKernel((const void*)fwd_mega, dim3(grid), dim3(512), kargs, LDS_BYTES, stream);
    if (e != hipSuccess) fprintf(stderr, "kernel_launch: cooperative launch failed: %s (grid %d)\n", hipGetErrorString(e), grid);
#else
    for (int ph = 0; ph < NPH; ++ph) { a.ph_lo = ph; a.ph_hi = ph + 1; hipLaunchKernelGGL(fwd_mega, dim3(grid), dim3(512), LDS_BYTES, stream, a); }
#endif
}
```

```cpp
#include <hip/hip_runtime.h>
#include <hip/hip_cooperative_groups.h>
#include <cstdio>
#include <cstdint>
namespace cg = cooperative_groups;

#ifndef ONE_LAUNCH
#define ONE_LAUNCH 1
#endif

#define LAS __attribute__((address_space(3)))
typedef unsigned short bf16_t;
typedef short bf16x8 __attribute__((ext_vector_type(8)));
typedef short s16x4 __attribute__((ext_vector_type(4)));
typedef float f32x4 __attribute__((ext_vector_type(4)));
typedef unsigned u32x4 __attribute__((ext_vector_type(4)));
typedef unsigned u32x2 __attribute__((ext_vector_type(2)));
typedef u32x4 u32x4_a4 __attribute__((aligned(4)));

__device__ __forceinline__ unsigned cvt_pk_bf16(float lo, float hi) { unsigned r; asm volatile("v_cvt_pk_bf16_f32 %0, %1, %2" : "=v"(r) : "v"(lo), "v"(hi)); return r; }
__device__ __forceinline__ float bf_lo(unsigned w) { return __uint_as_float(w << 16); }
__device__ __forceinline__ float bf_hi(unsigned w) { return __uint_as_float(w & 0xffff0000u); }
__device__ __forceinline__ float dot4(f32x4 a) { return (a[0] * a[0] + a[1] * a[1]) + (a[2] * a[2] + a[3] * a[3]); }

namespace pg8 {
#define PG8_LAS __attribute__((address_space(3)))
constexpr int BM = 256, BK = 64, HALF = 128, HTB = HALF * BK * 2, STAGE_BYTES = 8 * HTB, NXCD = 8, WGM = 8;
__host__ __device__ __forceinline__ int lds_byte(int r, int c) { const int st = (r >> 4) * 2 + (c >> 5), rr = r & 15, cc = c & 31, ob = rr * 64 + cc * 2; return st * 1024 + (ob ^ (((ob >> 9) & 1) << 5)); }
__host__ __device__ __forceinline__ void stage_rc(int b, int& R, int& C) { const int st = b / 1024, sb = b % 1024, swz = sb ^ (((sb >> 9) & 1) << 5); R = (st >> 1) * 16 + swz / 64; C = (st & 1) * 32 + (swz % 64) / 2; }
__host__ __device__ __forceinline__ int perm32(int rho) { const int n = rho >> 4, i = rho & 15; return 8 * (i >> 2) + 4 * n + (i & 3); }
struct Unit { int pm, pn; };
struct Gemm { const bf16_t* A; const bf16_t* Bt; int M, N, K; };
struct StaticOrder {
    int nM, nN, nwg, G, c;
    __host__ __device__ void init(int M, int N, int G_, int c_) { nM = M / BM; nN = N / BM; nwg = nM * nN; G = G_; c = c_; }
    __host__ __device__ bool next(int i, Unit& u) const {
        const long L = (long)i * G + c; if (L >= nwg) return false;
        int wgid = (int)L; { const int q = nwg / NXCD, r = nwg % NXCD, xcd = wgid % NXCD, off = wgid / NXCD; wgid = (xcd < r ? xcd * (q + 1) : r * (q + 1) + (xcd - r) * q) + off; }
        const int nig = WGM * nN, gid = wgid / nig, fm = gid * WGM, gsz = (nM - fm) < WGM ? (nM - fm) : WGM;
        u.pm = fm + ((wgid % nig) % gsz); u.pn = (wgid % nig) / gsz; return true;
    }
};
template <class Epi>
__device__ __forceinline__ void gemm_phase(PG8_LAS unsigned char* lds, PG8_LAS float* xl, const Gemm g, const StaticOrder& S, const Epi& E) {
    const int tid = threadIdx.x, wid = __builtin_amdgcn_readfirstlane(tid >> 6), lane = tid & 63, wr = wid >> 2, wc = wid & 3, fr = lane & 15, fq = lane >> 4;
    const int K = g.K, nt = K / BK;
    unsigned voffA[2], voffB[2];
#pragma unroll
    for (int i = 0; i < 2; ++i) { int R, C; stage_rc(tid * 16 + i * 8192, R, C); const int Rb = (R & ~31) + perm32(R & 31);
        voffA[i] = (unsigned)(R * K + C) * 2u; voffB[i] = (unsigned)(Rb * K + C) * 2u; }
    const size_t kstep = (size_t)(BK * 2);
    const size_t hstep = (size_t)HALF * K * 2;
    const size_t tstep = 2 * hstep;
    const unsigned ldsw = (unsigned)wid * 1024u;
    const int aoff = lds_byte(wr * 64 + fr, fq * 8), boff = lds_byte(wc * 32 + fr, fq * 8);
#define PG8_SA(b, h) (((b) * 2 + (h)) * HTB)
#define PG8_SB(b, h) ((4 + (b) * 2 + (h)) * HTB)
#define PG8_STAGE(bufoff, gbase, voff) do { _Pragma("unroll") for (int _i = 0; _i < 2; ++_i) \
        __builtin_amdgcn_global_load_lds((const unsigned*)((const char*)(gbase) + (voff)[_i]), (PG8_LAS unsigned*)(lds + (bufoff) + ldsw + _i * 8192), 16, 0, 0); } while (0)
#define PG8_LDA(dst, b, h) do { _Pragma("unroll") for (int m = 0; m < 4; ++m) _Pragma("unroll") for (int k = 0; k < 2; ++k) dst[m][k] = *(const PG8_LAS bf16x8*)(lds + PG8_SA(b, h) + aoff + m * 2048 + k * 1024); } while (0)
#define PG8_LDB(dst, b, h) do { _Pragma("unroll") for (int n = 0; n < 2; ++n) _Pragma("unroll") for (int k = 0; k < 2; ++k) dst[n][k] = *(const PG8_LAS bf16x8*)(lds + PG8_SB(b, h) + boff + n * 2048 + k * 1024); } while (0)
#define PG8_MMA(ai, bj, At, Bt) do { __builtin_amdgcn_s_setprio(1); _Pragma("unroll") for (int m = 0; m < 4; ++m) _Pragma("unroll") for (int n = 0; n < 2; ++n) _Pragma("unroll") for (int k = 0; k < 2; ++k) \
        acc[ai][bj][m][n] = __builtin_amdgcn_mfma_f32_16x16x32_bf16(Bt[n][k], At[m][k], acc[ai][bj][m][n], 0, 0, 0); __builtin_amdgcn_s_setprio(0); } while (0)
#define PG8_WAIT_V(n) asm volatile("s_waitcnt vmcnt(" #n ")" ::: "memory")
#define PG8_WAIT_L(n) asm volatile("s_waitcnt lgkmcnt(" #n ")" ::: "memory")
#define PG8_BAR __builtin_amdgcn_s_barrier()
#define PG8_SCHED __builtin_amdgcn_sched_barrier(0)
    Unit cur, nxt; int ui = 0;
    if (!S.next(0, cur)) return;
    f32x4 acc[2][2][4][2];
#pragma unroll
    for (int a = 0; a < 2; ++a)
#pragma unroll
        for (int b = 0; b < 2; ++b)
#pragma unroll
            for (int m = 0; m < 4; ++m)
#pragma unroll
                for (int n = 0; n < 2; ++n) acc[a][b][m][n] = (f32x4){0.f, 0.f, 0.f, 0.f};
    bf16x8 At[4][2], B0[2][2], B1[2][2];
    const char* cA = (const char*)g.A + (size_t)cur.pm * tstep; const char* cB = (const char*)g.Bt + (size_t)cur.pn * tstep;
    PG8_STAGE(PG8_SB(0, 0), cB, voffB); PG8_STAGE(PG8_SB(0, 1), cB + hstep, voffB); PG8_STAGE(PG8_SA(0, 0), cA, voffA); PG8_STAGE(PG8_SA(0, 1), cA + hstep, voffA);
    if (wr == 1) PG8_BAR;
    PG8_WAIT_V(2); PG8_BAR;
    PG8_STAGE(PG8_SB(1, 0), cB + kstep, voffB); PG8_STAGE(PG8_SA(1, 0), cA + kstep, voffA); PG8_STAGE(PG8_SB(1, 1), cB + hstep + kstep, voffB);
    PG8_WAIT_V(6); PG8_BAR;
    for (;;) {
        const bool has_next = S.next(ui + 1, nxt);
        const char* nA = has_next ? (const char*)g.A + (size_t)nxt.pm * tstep : cA; const char* nB = has_next ? (const char*)g.Bt + (size_t)nxt.pn * tstep : cB;
        for (int t = 0; t < nt; t += 2) {
            const bool last = (t == nt - 2);
            const char* a1 = cA + (size_t)(t + 1) * kstep;
            const char* a2 = last ? nA : cA + (size_t)(t + 2) * kstep; const char* b2 = last ? nB : cB + (size_t)(t + 2) * kstep;
            const char* a3 = a2 + kstep; const char* b3 = b2 + kstep;
            PG8_LDB(B0, 0, 0); PG8_LDB(B1, 0, 1); PG8_SCHED; PG8_LDA(At, 0, 0); PG8_STAGE(PG8_SA(1, 1), a1 + hstep, voffA);
            PG8_WAIT_V(8); PG8_WAIT_L(0); PG8_BAR; PG8_MMA(0, 0, At, B0); PG8_MMA(0, 1, At, B1); PG8_BAR; PG8_SCHED;
            PG8_LDA(At, 0, 1); PG8_STAGE(PG8_SB(0, 0), b2, voffB); PG8_STAGE(PG8_SB(0, 1), b2 + hstep, voffB); PG8_STAGE(PG8_SA(0, 0), a2, voffA);
            PG8_WAIT_V(8); PG8_WAIT_L(0); PG8_BAR; PG8_MMA(1, 0, At, B0); PG8_MMA(1, 1, At, B1); PG8_BAR; PG8_SCHED;
            PG8_LDB(B0, 1, 0); PG8_LDB(B1, 1, 1); PG8_SCHED; PG8_LDA(At, 1, 0); PG8_STAGE(PG8_SA(0, 1), a2 + hstep, voffA);
            PG8_WAIT_V(8); PG8_WAIT_L(0); PG8_BAR; PG8_MMA(0, 0, At, B0); PG8_MMA(0, 1, At, B1); PG8_BAR; PG8_SCHED;
            PG8_LDA(At, 1, 1); PG8_STAGE(PG8_SB(1, 0), b3, voffB); PG8_STAGE(PG8_SB(1, 1), b3 + hstep, voffB); PG8_STAGE(PG8_SA(1, 0), a3, voffA);
            PG8_WAIT_V(8); PG8_WAIT_L(0); PG8_BAR; PG8_MMA(1, 0, At, B0); PG8_MMA(1, 1, At, B1); PG8_BAR; PG8_SCHED;
        }
        if (wr == 0) PG8_BAR;
        E(acc, cur, wr, wc, fr, fq, xl);
        if (!has_next) break;
#pragma unroll
        for (int a = 0; a < 2; ++a)
#pragma unroll
            for (int b = 0; b < 2; ++b)
#pragma unroll
                for (int m = 0; m < 4; ++m)
#pragma unroll
                    for (int n = 0; n < 2; ++n) acc[a][b][m][n] = (f32x4){0.f, 0.f, 0.f, 0.f};
        cur = nxt; cA = nA; cB = nB; ++ui;
        if (wr == 1) PG8_BAR;
    }
    PG8_WAIT_V(0);
    PG8_BAR;
#undef PG8_SA
#undef PG8_SB
#undef PG8_STAGE
#undef PG8_LDA
#undef PG8_LDB
#undef PG8_MMA
#undef PG8_WAIT_V
#undef PG8_WAIT_L
#undef PG8_BAR
#undef PG8_SCHED
}
}

constexpr int MTOK = 32768, DM = 2048, SEQ = 4096, NB = 8, INW = 6144, FF = 5632, PLE = 256, AW = 1024, HW = 1024;
constexpr float EPS = 1e-6f;
constexpr size_t MiB = (size_t)1 << 20;
constexpr size_t WS_WIN = 0, WS_WOUT = 24 * MiB, WS_WGU = 32 * MiB, WS_WDOWN = 76 * MiB, WS_WGATE = 98 * MiB, WS_WPROJ = 106 * MiB;
constexpr size_t WS_HR = 107 * MiB;
constexpr size_t WS_SMALL = 124 * MiB;
constexpr size_t WS_RSTDX = WS_SMALL, WS_SSE = WS_SMALL + 128 * 1024, WS_SS1 = WS_SMALL + 256 * 1024, WS_SS2 = WS_SMALL + 384 * 1024, WS_BTAB = WS_SMALL + 512 * 1024, WS_LSE = WS_SMALL + MiB;
constexpr size_t WS_BAR = WS_SMALL + 640 * 1024;
constexpr size_t WS_OG = 128 * MiB, WS_ERAW = 128 * MiB, WS_XB = 256 * MiB, WS_H2B = 256 * MiB, WS_PB = 384 * MiB;
constexpr size_t WS_Q = 400 * MiB, WS_K = 464 * MiB, WS_V = 528 * MiB, WS_YT = 400 * MiB, WS_H1B = 464 * MiB;
constexpr size_t WS_HY = 592 * MiB, WS_Y = 592 * MiB, WS_ACT = 592 * MiB, WS_ZT = 784 * MiB, WS_X0T = 848 * MiB, WS_END = 944 * MiB;
constexpr int HRLEN = 8320, HROFF = 4160;
constexpr int LDS_BYTES = 155648;
constexpr int XL_OFF = 131072, BARST_OFF = LDS_BYTES - 16;
constexpr int NPH = 9;

struct Args { const float* in[27]; float* out; unsigned char* ws; int ph_lo, ph_hi; };

using pg8::Unit;
struct EpiIn {
    unsigned char* ws; const float* qg; const float* kg;
    __device__ __forceinline__ void operator()(const f32x4 (&acc)[2][2][4][2], const Unit& u, int wr, int wc, int fr, int fq, LAS float* P) const {
        const float* rstd = (const float*)(ws + WS_RSTDX);
        const int rowl0 = wr * 64 + fr, row0 = u.pm * 256 + rowl0;
        if (u.pn < 8) {
#pragma unroll
            for (int ai = 0; ai < 2; ++ai)
#pragma unroll
                for (int m = 0; m < 4; ++m) { const float rs = rstd[row0 + ai * 128 + m * 16];
#pragma unroll
                    for (int bj = 0; bj < 2; ++bj) { float s = (dot4(acc[ai][bj][m][0]) + dot4(acc[ai][bj][m][1])) * rs * rs;
                        s += __shfl_xor(s, 16); s += __shfl_xor(s, 32);
                        if (fq == 0) P[((rowl0 + ai * 128 + m * 16) * 2 + bj) * 4 + wc] = s; } }
            asm volatile("s_waitcnt lgkmcnt(0)" ::: "memory"); __builtin_amdgcn_s_barrier(); asm volatile("" ::: "memory");
            const bool isq = u.pn < 4; const float* gp = (isq ? qg : kg) + wc * 32 + fq * 8; const float sc = isq ? 0.08838834764831845f : 1.0f;
            const f32x4 g0 = *(const f32x4*)gp * sc, g1 = *(const f32x4*)(gp + 4) * sc;
            bf16_t* base = (bf16_t*)(ws + (isq ? WS_Q : WS_K)) + (u.pn & 3) * 256 + wc * 32 + fq * 8;
#pragma unroll
            for (int ai = 0; ai < 2; ++ai)
#pragma unroll
                for (int m = 0; m < 4; ++m) { const int rl = rowl0 + ai * 128 + m * 16; const float rs = rstd[row0 + ai * 128 + m * 16];
#pragma unroll
                    for (int bj = 0; bj < 2; ++bj) { const f32x4 pp = *(const LAS f32x4*)(P + (rl * 2 + bj) * 4);
                        const float tot = (pp[0] + pp[1]) + (pp[2] + pp[3]); const float r = rs * __builtin_amdgcn_rsqf(tot * (1.0f / 128.0f) + EPS);
                        const f32x4 v0 = acc[ai][bj][m][0] * r * g0, v1 = acc[ai][bj][m][1] * r * g1;
                        u32x4 w; w.x = cvt_pk_bf16(v0[0], v0[1]); w.y = cvt_pk_bf16(v0[2], v0[3]); w.z = cvt_pk_bf16(v1[0], v1[1]); w.w = cvt_pk_bf16(v1[2], v1[3]);
                        *(u32x4*)(base + (size_t)(u.pm * 256 + rl) * 1024 + bj * 128) = w; } }
        } else {
            const bool isv = u.pn < 12; const int ld = isv ? 1024 : 3072;
            bf16_t* base = (bf16_t*)(ws + (isv ? WS_V : WS_HY)) + (isv ? (u.pn - 8) : (u.pn - 12)) * 256 + wc * 32 + fq * 8;
#pragma unroll
            for (int ai = 0; ai < 2; ++ai)
#pragma unroll
                for (int m = 0; m < 4; ++m) { const int row = row0 + ai * 128 + m * 16; const float rs = rstd[row];
#pragma unroll
                    for (int bj = 0; bj < 2; ++bj) { const f32x4 v0 = acc[ai][bj][m][0] * rs, v1 = acc[ai][bj][m][1] * rs;
                        u32x4 w; w.x = cvt_pk_bf16(v0[0], v0[1]); w.y = cvt_pk_bf16(v0[2], v0[3]); w.z = cvt_pk_bf16(v1[0], v1[1]); w.w = cvt_pk_bf16(v1[2], v1[3]);
                        *(u32x4*)(base + (size_t)row * ld + bj * 128) = w; } }
        }
    }
};
struct EpiOut {
    const float* base; bf16_t* ob; float* ss;
    __device__ __forceinline__ void operator()(const f32x4 (&acc)[2][2][4][2], const Unit& u, int wr, int wc, int fr, int fq, LAS float*) const {
        const int row0 = u.pm * 256 + wr * 64 + fr, col0 = u.pn * 256 + wc * 32 + fq * 8;
#pragma unroll
        for (int ai = 0; ai < 2; ++ai)
#pragma unroll
            for (int m = 0; m < 4; ++m) { const int row = row0 + ai * 128 + m * 16; float s = 0.f;
#pragma unroll
                for (int bj = 0; bj < 2; ++bj) { const size_t off = (size_t)row * DM + col0 + bj * 128;
                    const f32x4 h0 = *(const f32x4*)(base + off) + acc[ai][bj][m][0], h1 = *(const f32x4*)(base + off + 4) + acc[ai][bj][m][1];
                    u32x4 w; w.x = cvt_pk_bf16(h0[0], h0[1]); w.y = cvt_pk_bf16(h0[2], h0[3]); w.z = cvt_pk_bf16(h1[0], h1[1]); w.w = cvt_pk_bf16(h1[2], h1[3]);
                    *(u32x4*)(ob + off) = w; s += dot4(h0) + dot4(h1); }
                s += __shfl_xor(s, 16); s += __shfl_xor(s, 32);
                if (fq == 0) atomicAdd(ss + row, s);
                asm volatile("" ::: "memory"); }
    }
};
struct EpiDown {
    const bf16_t* hb; bf16_t* ob; float* ss;
    __device__ __forceinline__ void operator()(const f32x4 (&acc)[2][2][4][2], const Unit& u, int wr, int wc, int fr, int fq, LAS float*) const {
        const int row0 = u.pm * 256 + wr * 64 + fr, col0 = u.pn * 256 + wc * 32 + fq * 8;
#pragma unroll
        for (int ai = 0; ai < 2; ++ai)
#pragma unroll
            for (int m = 0; m < 4; ++m) { const int row = row0 + ai * 128 + m * 16; float s = 0.f;
#pragma unroll
                for (int bj = 0; bj < 2; ++bj) { const size_t off = (size_t)row * DM + col0 + bj * 128; const u32x4 hw = *(const u32x4*)(hb + off);
                    const f32x4 h0 = (f32x4){bf_lo(hw.x), bf_hi(hw.x), bf_lo(hw.y), bf_hi(hw.y)} + acc[ai][bj][m][0], h1 = (f32x4){bf_lo(hw.z), bf_hi(hw.z), bf_lo(hw.w), bf_hi(hw.w)} + acc[ai][bj][m][1];
                    u32x4 w; w.x = cvt_pk_bf16(h0[0], h0[1]); w.y = cvt_pk_bf16(h0[2], h0[3]); w.z = cvt_pk_bf16(h1[0], h1[1]); w.w = cvt_pk_bf16(h1[2], h1[3]);
                    *(u32x4*)(ob + off) = w; s += dot4(h0) + dot4(h1); }
                s += __shfl_xor(s, 16); s += __shfl_xor(s, 32);
                if (fq == 0) atomicAdd(ss + row, s);
                asm volatile("" ::: "memory"); }
    }
};
struct EpiProj {
    bf16_t* ob; float* ss;
    __device__ __forceinline__ void operator()(const f32x4 (&acc)[2][2][4][2], const Unit& u, int wr, int wc, int fr, int fq, LAS float*) const {
        const int row0 = u.pm * 256 + wr * 64 + fr, col0 = u.pn * 256 + wc * 32 + fq * 8;
#pragma unroll
        for (int ai = 0; ai < 2; ++ai)
#pragma unroll
            for (int m = 0; m < 4; ++m) { const int row = row0 + ai * 128 + m * 16; float s = 0.f;
#pragma unroll
                for (int bj = 0; bj < 2; ++bj) { const size_t off = (size_t)row * DM + col0 + bj * 128; const f32x4 h0 = acc[ai][bj][m][0], h1 = acc[ai][bj][m][1];
                    u32x4 w; w.x = cvt_pk_bf16(h0[0], h0[1]); w.y = cvt_pk_bf16(h0[2], h0[3]); w.z = cvt_pk_bf16(h1[0], h1[1]); w.w = cvt_pk_bf16(h1[2], h1[3]);
                    *(u32x4*)(ob + off) = w; s += dot4(h0) + dot4(h1); }
                s += __shfl_xor(s, 16); s += __shfl_xor(s, 32);
                if (fq == 0) atomicAdd(ss + row, s); }
    }
};
struct EpiGU {
    bf16_t* act; const float* ss;
    __device__ __forceinline__ void operator()(const f32x4 (&acc)[2][2][4][2], const Unit& u, int wr, int wc, int fr, int fq, LAS float*) const {
        const int row0 = u.pm * 256 + wr * 64 + fr, col0 = u.pn * 128 + wc * 32 + fq * 8;
#pragma unroll
        for (int ai = 0; ai < 2; ++ai)
#pragma unroll
            for (int m = 0; m < 4; ++m) { const int row = row0 + ai * 128 + m * 16; const float rs = __builtin_amdgcn_rsqf(ss[row] * (1.0f / DM) + EPS);
                float o[8];
#pragma unroll
                for (int n = 0; n < 2; ++n)
#pragma unroll
                    for (int j = 0; j < 4; ++j) { const float a = acc[ai][0][m][n][j] * rs, gg = acc[ai][1][m][n][j] * rs;
                        o[n * 4 + j] = a * __builtin_amdgcn_rcpf(1.0f + __expf(-a)) * gg; }
                u32x4 w; w.x = cvt_pk_bf16(o[0], o[1]); w.y = cvt_pk_bf16(o[2], o[3]); w.z = cvt_pk_bf16(o[4], o[5]); w.w = cvt_pk_bf16(o[6], o[7]);
                *(u32x4*)(act + (size_t)row * FF + col0) = w; }
    }
};
struct EpiGate {
    float* out; const bf16_t* hb; const bf16_t* eraw; const float* ss2; const float* ssE; const float* post;
    __device__ __forceinline__ void operator()(const f32x4 (&acc)[2][2][4][2], const Unit& u, int wr, int wc, int fr, int fq, LAS float*) const {
        const int row0 = u.pm * 256 + wr * 64 + fr, col0 = u.pn * 256 + wc * 32 + fq * 8;
#pragma unroll
        for (int ai = 0; ai < 2; ++ai)
#pragma unroll
            for (int m = 0; m < 4; ++m) { const int row = row0 + ai * 128 + m * 16;
                const float rs2 = __builtin_amdgcn_rsqf(ss2[row] * (1.0f / DM) + EPS), rsE = __builtin_amdgcn_rsqf(ssE[row] * (1.0f / DM) + EPS);
#pragma unroll
                for (int bj = 0; bj < 2; ++bj) { const size_t off = (size_t)row * DM + col0 + bj * 128;
                    const u32x4 ew = *(const u32x4*)(eraw + off); const f32x4 p0 = *(const f32x4*)(post + col0 + bj * 128), p1 = *(const f32x4*)(post + col0 + bj * 128 + 4);
                    const f32x4 e0 = (f32x4){bf_lo(ew.x), bf_hi(ew.x), bf_lo(ew.y), bf_hi(ew.y)} * rsE * p0, e1 = (f32x4){bf_lo(ew.z), bf_hi(ew.z), bf_lo(ew.w), bf_hi(ew.w)} * rsE * p1;
                    const u32x4 hw = *(const u32x4*)(hb + off);
                    f32x4 h0 = (f32x4){bf_lo(hw.x), bf_hi(hw.x), bf_lo(hw.y), bf_hi(hw.y)}, h1 = (f32x4){bf_lo(hw.z), bf_hi(hw.z), bf_lo(hw.w), bf_hi(hw.w)};
#pragma unroll
                    for (int j = 0; j < 4; ++j) { h0[j] += __builtin_amdgcn_rcpf(1.0f + __expf(-acc[ai][bj][m][0][j] * rs2)) * e0[j]; h1[j] += __builtin_amdgcn_rcpf(1.0f + __expf(-acc[ai][bj][m][1][j] * rs2)) * e1[j]; }
                    *(f32x4*)(out + off) = h0; *(f32x4*)(out + off + 4) = h1; }
                asm volatile("" ::: "memory"); }
    }
};

__device__ __forceinline__ void p0_transpose_blk(const float* W, const float* gain, int K, int N, bf16_t* WT, int gu, LAS unsigned char* T, int item) {
    const int tid = threadIdx.x, lane = tid & 63, w = __builtin_amdgcn_readfirstlane(tid >> 6);
    const int nblk = N / 256, kb = item / nblk, nb = item % nblk, k0 = 64 * kb, n0 = 256 * nb;
    f32x4 v[8];
#pragma unroll
    for (int i = 0; i < 8; ++i) v[i] = *(const f32x4*)(W + (size_t)(k0 + 8 * w + i) * N + n0 + 4 * lane);
    if (gain) {
#pragma unroll
        for (int i = 0; i < 8; ++i) v[i] *= gain[k0 + 8 * w + i]; }
#pragma unroll
    for (int j = 0; j < 4; ++j) { u32x4 o; o.x = cvt_pk_bf16(v[0][j], v[1][j]); o.y = cvt_pk_bf16(v[2][j], v[3][j]); o.z = cvt_pk_bf16(v[4][j], v[5][j]); o.w = cvt_pk_bf16(v[6][j], v[7][j]);
        *(LAS u32x4*)(T + (4 * lane + j) * 128 + ((w ^ (lane & 7)) * 16)) = o; }
    __syncthreads();
    int ndb = n0;
    if (gu) { const int s = n0 >= FF ? 1 : 0, j = n0 - s * FF; ndb = 256 * (j >> 7) + 128 * s; }
#pragma unroll
    for (int i = 0; i < 4; ++i) { const int id = tid + 512 * i, n = id >> 3, c = id & 7;
        const u32x4 o = *(const LAS u32x4*)(T + n * 128 + ((c ^ ((n >> 2) & 7)) * 16));
        const int nd = gu ? (ndb + 256 * (n >> 7) + (n & 127)) : (n0 + n);
        *(u32x4*)(WT + (size_t)nd * K + k0 + 8 * c) = o; }
    __syncthreads();
}
__device__ __forceinline__ float wave_sum(float v) {
#pragma unroll
    for (int o = 1; o < 64; o <<= 1) v += __shfl_xor(v, o);
    return v;
}
__device__ __forceinline__ int t5_bucket(int rel) {
    const int n = rel < 0 ? -rel : rel;
    int large = 8 + (int)(logf((float)(n < 1 ? 1 : n) / 8.0f) / logf(128.0f) * 8.0f);
    if (large > 15) large = 15;
    return (rel > 0 ? 16 : 0) + (n < 8 ? n : large);
}
__device__ __forceinline__ void p0_prologue(const Args& A, LAS unsigned char* lds) {
    const int tid = threadIdx.x, lane = tid & 63, wave = tid >> 6, G = gridDim.x, gw = blockIdx.x * 8 + wave, NGW = G * 8;
    unsigned char* ws = A.ws;
    {
        constexpr int I_IN = 32 * 24, I_OUT = 32 * 8, I_GU = 32 * 44, I_DN = 88 * 8, I_GT = 32 * 8, I_PJ = 4 * 8;
        constexpr int NIT = I_IN + I_OUT + I_GU + I_DN + I_GT + I_PJ;
        for (int it = blockIdx.x; it < NIT; it += G) {
            int r = it;
            if (r < I_IN) { p0_transpose_blk(A.in[4], A.in[3], DM, INW, (bf16_t*)(ws + WS_WIN), 0, lds, r); continue; } r -= I_IN;
            if (r < I_OUT) { p0_transpose_blk(A.in[19], nullptr, DM, DM, (bf16_t*)(ws + WS_WOUT), 0, lds, r); continue; } r -= I_OUT;
            if (r < I_GU) { p0_transpose_blk(A.in[21], A.in[20], DM, 2 * FF, (bf16_t*)(ws + WS_WGU), 1, lds, r); continue; } r -= I_GU;
            if (r < I_DN) { p0_transpose_blk(A.in[22], nullptr, FF, DM, (bf16_t*)(ws + WS_WDOWN), 0, lds, r); continue; } r -= I_DN;
            if (r < I_GT) { p0_transpose_blk(A.in[24], A.in[23], DM, DM, (bf16_t*)(ws + WS_WGATE), 0, lds, r); continue; } r -= I_GT;
            p0_transpose_blk(A.in[25], nullptr, PLE, DM, (bf16_t*)(ws + WS_WPROJ), 0, lds, r);
        }
    }
    {
        const float* x = A.in[0]; bf16_t* xb = (bf16_t*)(ws + WS_XB); float* rstd = (float*)(ws + WS_RSTDX);
        for (int m = gw; m < MTOK; m += NGW) {
            const f32x4* xr = (const f32x4*)(x + (size_t)m * DM) + lane; f32x4 v[8]; float s = 0.f;
#pragma unroll
            for (int j = 0; j < 8; ++j) { v[j] = xr[64 * j]; s += dot4(v[j]); }
            s = wave_sum(s);
            if (lane == 0) rstd[m] = 1.0f / sqrtf(s * (1.0f / DM) + EPS);
            u32x2* o = (u32x2*)(xb + (size_t)m * DM) + lane;
#pragma unroll
            for (int j = 0; j < 8; ++j) { u32x2 w; w.x = cvt_pk_bf16(v[j][0], v[j][1]); w.y = cvt_pk_bf16(v[j][2], v[j][3]); o[64 * j] = w; }
        }
    }
    {
        const size_t gt = (size_t)blockIdx.x * 512 + tid, NT = (size_t)G * 512;
        const f32x4* p4 = (const f32x4*)A.in[1]; u32x2* pb = (u32x2*)(ws + WS_PB);
        _Pragma("unroll 4") for (size_t i = gt; i < (size_t)MTOK * PLE / 4; i += NT) { const f32x4 v = p4[i]; u32x2 w; w.x = cvt_pk_bf16(v[0], v[1]); w.y = cvt_pk_bf16(v[2], v[3]); pb[i] = w; }
        float* z = (float*)(ws + WS_SSE);
        for (size_t i = gt; i < 3 * (size_t)MTOK; i += NT) z[i] = 0.f;
        if (blockIdx.x == 0) { unsigned* bw = (unsigned*)(ws + WS_BAR); for (int i = tid; i < 3456; i += 512) bw[i] = 0u;
            float* bt = (float*)(ws + WS_BTAB); const float* rb = A.in[2];
            for (int i = tid; i < 3 * 8 * 129; i += 512) { const int g = i / (8 * 129), h = (i / 129) % 8, rel = i % 129 - 64; const int d = g == 0 ? 1 : (g == 1 ? 4 : 16);
                bt[i] = rb[t5_bucket(rel * d) * 8 + h]; } }
    }
    {
        LAS float* zf = (LAS float*)lds;
        LAS float* hA = zf + 16 * 33;
        LAS float* hB = hA + 16 * 64;
        const float* w1 = A.in[9]; const float* b1 = A.in[10]; const float* wi = A.in[11]; const float* bi = A.in[12]; const float* wo = A.in[13];
        const float* fq = A.in[14]; const float* dec = A.in[15]; const float* hb = A.in[16];
        bf16_t* hr = (bf16_t*)(ws + WS_HR);
        __syncthreads();
        for (int z = blockIdx.x; z < 263; z += G) { const int q = z < 132 ? z : z + 257;
            for (int c = tid; c < HW; c += 512) { u32x4* d = (u32x4*)(hr + (size_t)c * HRLEN + 16 * q); d[0] = (u32x4){0u, 0u, 0u, 0u}; d[1] = (u32x4){0u, 0u, 0u, 0u}; } }
        for (int r = blockIdx.x; r < 256; r += G) {
            const bool edge = (r == 255);
#define FPOS(sl) (edge ? ((sl) < 15 ? 4095 - (sl) : 0) : (HROFF + 2048 - (16 * (133 + r) + (sl))))
            for (int t = tid; t < 16 * 33; t += 512) { const int pi = t / 33, f = t % 33; const float pos = (float)FPOS(pi); float v;
                if (f == 0) v = pos / 4095.0f;
                else { const int k = (f - 1) & 15; const float fr = 1e-4f + (float)k * ((15.0f - 1e-4f) / 15.0f); const float ang = ((float)(2.0 * 3.14159265358979323846 / 4096.0) * pos) * fr;
                    v = (f <= 16) ? cosf(ang) : -sinf(ang); }
                zf[t] = v; }
            __syncthreads();
#pragma unroll
            for (int h2 = 0; h2 < 2; ++h2) { const int e = tid + 512 * h2, pi = e >> 6, uu = e & 63; float sacc = b1[uu];
                _Pragma("unroll 11") for (int f = 0; f < 33; ++f) sacc += zf[pi * 33 + f] * w1[f * 64 + uu];
                hA[pi * 64 + uu] = sinf(fq[uu] * sacc); }
            __syncthreads();
#pragma unroll
            for (int h2 = 0; h2 < 2; ++h2) { const int e = tid + 512 * h2, pi = e >> 6, uu = e & 63; float sacc = bi[uu];
                _Pragma("unroll 4") for (int k4 = 0; k4 < 16; ++k4) { const f32x4 hv = *(const LAS f32x4*)(hA + pi * 64 + 4 * k4); sacc += (hv[0] * wi[(4 * k4) * 64 + uu] + hv[1] * wi[(4 * k4 + 1) * 64 + uu]) + (hv[2] * wi[(4 * k4 + 2) * 64 + uu] + hv[3] * wi[(4 * k4 + 3) * 64 + uu]); }
                hB[pi * 64 + uu] = sinf(fq[uu] * sacc); }
            __syncthreads();
#pragma unroll
            for (int h2 = 0; h2 < 2; ++h2) { const int e = tid + 512 * h2, pi = e >> 6, uu = e & 63; float sacc = bi[64 + uu];
                _Pragma("unroll 4") for (int k4 = 0; k4 < 16; ++k4) { const f32x4 hv = *(const LAS f32x4*)(hB + pi * 64 + 4 * k4); sacc += (hv[0] * wi[4096 + (4 * k4) * 64 + uu] + hv[1] * wi[4096 + (4 * k4 + 1) * 64 + uu]) + (hv[2] * wi[4096 + (4 * k4 + 2) * 64 + uu] + hv[3] * wi[4096 + (4 * k4 + 3) * 64 + uu]); }
                hA[pi * 64 + uu] = sinf(fq[uu] * sacc); }
            __syncthreads();
#pragma unroll 1
            for (int cc = 0; cc < 2; ++cc) { const int c = tid + 512 * cc; float a[16];
#pragma unroll
                for (int pi = 0; pi < 16; ++pi) a[pi] = 0.f;
                _Pragma("unroll 2") for (int k4 = 0; k4 < 16; ++k4) {
                    const float w0 = wo[(4 * k4 + 0) * HW + c], w1 = wo[(4 * k4 + 1) * HW + c], w2 = wo[(4 * k4 + 2) * HW + c], w3 = wo[(4 * k4 + 3) * HW + c];
#pragma unroll
                    for (int pi = 0; pi < 16; ++pi) { const f32x4 hv = *(const LAS f32x4*)(hA + pi * 64 + 4 * k4); a[pi] += (hv[0] * w0 + hv[1] * w1) + (hv[2] * w2 + hv[3] * w3); } }
                const float ad = fabsf(dec[c]);
#pragma unroll
                for (int pi = 0; pi < 16; ++pi) { const int p = FPOS(pi); const int ao = p >= 2048 ? p - 2048 : 2048 - p; const float offs = (float)ao * (1.0f / 2048.0f);
                    float v = a[pi] * expf(-offs * ad); if (p == 2048) v += hb[c]; a[pi] = v; }
                bf16_t* row = hr + (size_t)c * HRLEN;
                if (!edge) { u32x4* d = (u32x4*)(row + 16 * (133 + r));
                    d[0] = (u32x4){cvt_pk_bf16(a[0], a[1]), cvt_pk_bf16(a[2], a[3]), cvt_pk_bf16(a[4], a[5]), cvt_pk_bf16(a[6], a[7])};
                    d[1] = (u32x4){cvt_pk_bf16(a[8], a[9]), cvt_pk_bf16(a[10], a[11]), cvt_pk_bf16(a[12], a[13]), cvt_pk_bf16(a[14], a[15])}; }
                else { u32x4* dA = (u32x4*)(row + 2112); u32x4* dB = (u32x4*)(row + 6208);
                    dA[0] = (u32x4){cvt_pk_bf16(0.f, a[0]), cvt_pk_bf16(a[1], a[2]), cvt_pk_bf16(a[3], a[4]), cvt_pk_bf16(a[5], a[6])};
                    dA[1] = (u32x4){cvt_pk_bf16(a[7], a[8]), cvt_pk_bf16(a[9], a[10]), cvt_pk_bf16(a[11], a[12]), cvt_pk_bf16(a[13], a[14])};
                    dB[0] = (u32x4){cvt_pk_bf16(a[15], 0.f), 0u, 0u, 0u}; dB[1] = (u32x4){0u, 0u, 0u, 0u}; } }
            __syncthreads();
#undef FPOS
        }
    }
}

constexpr int KPITCH = 272, VPITCH = 288, AT_VS = 256 * KPITCH, AT_BT = AT_VS + 272 * VPITCH;
constexpr int ATT_ITEMS = 6144;
__device__ __forceinline__ void att_decode(int item, int& g, int& b, int& h, int& r, int& n0, int& dsh) {
    g = item >> 11; const int rem = item & 2047, bh = rem >> 5, sub = rem & 31; b = bh >> 3; h = bh & 7;
    dsh = g == 0 ? 0 : (g == 1 ? 2 : 4); const int psh = g == 0 ? 5 : (g == 1 ? 3 : 1);
    r = sub >> psh; n0 = 2 * (sub & ((1 << psh) - 1));
}
__device__ __forceinline__ void att_issue(const unsigned char* ws, int item, int tid, int wave, int lane, u32x4 (&pre)[16], bf16x8 (&qpre)[4], float& bpre, unsigned& vmask) {
    int g, b, h, r, n0, dsh; att_decode(item, g, b, h, r, n0, dsh);
    const int Ls = SEQ >> dsh, tokbase = b * SEQ;
    const bf16_t* Qp = (const bf16_t*)(ws + WS_Q); const bf16_t* Kp = (const bf16_t*)(ws + WS_K); const bf16_t* Vp = (const bf16_t*)(ws + WS_V);
    unsigned vm = 0u;
#pragma unroll
    for (int i = 0; i < 16; ++i) { const int c2 = (tid + 512 * i) & 4095, ki = c2 >> 4, cc = c2 & 15, idx = 64 * (n0 - 1) + ki;
        const bool ok = idx >= 0 && idx < Ls; const int pos = ((ok ? idx : 0) << dsh) + r;
        pre[i] = *(const u32x4*)((i < 8 ? Kp : Vp) + (size_t)(tokbase + pos) * AW + h * 128 + cc * 8);
        vm |= (ok ? 1u : 0u) << i; }
    vmask = vm;
    { const int qb = wave >> 2, t = wave & 3, idxq = 64 * (n0 + qb) + 16 * t + (lane & 15); const int tokq = tokbase + (idxq << dsh) + r;
        const bf16_t* qp = Qp + (size_t)tokq * AW + h * 128 + 8 * (lane >> 4);
#pragma unroll
        for (int kk = 0; kk < 4; ++kk) qpre[kk] = *(const bf16x8*)(qp + 32 * kk); }
    { const int bi = tid - 15; bpre = ((const float*)(ws + WS_BTAB))[(g * 8 + h) * 129 + (bi < 0 ? 0 : (bi > 128 ? 128 : bi))]; }
}
__device__ __forceinline__ void att_body(unsigned char* ws, LAS unsigned char* ks, LAS unsigned char* vs, LAS float* btab, int item, int nxt, int tid, int wave, int lane,
                                         u32x4 (&pre)[16], bf16x8 (&qpre)[4], float& bpre, unsigned& vmask) {
#pragma unroll
        for (int i = 0; i < 16; ++i) { const int c2 = (tid + 512 * i) & 4095, ki = c2 >> 4, cc = c2 & 15;
            u32x4 v = pre[i]; if (!((vmask >> i) & 1u)) v = (u32x4){0u, 0u, 0u, 0u};
            if (i < 8) *(LAS u32x4*)(ks + ki * KPITCH + cc * 16) = v; else *(LAS u32x4*)(vs + ki * VPITCH + cc * 16) = v; }
        if (tid < 160) btab[tid] = (tid >= 15 && tid <= 143) ? bpre : -1.0e30f;
        bf16x8 qf[4];
#pragma unroll
        for (int kk = 0; kk < 4; ++kk) qf[kk] = qpre[kk];
        asm volatile("s_waitcnt lgkmcnt(0)" ::: "memory"); __builtin_amdgcn_s_barrier(); asm volatile("" ::: "memory");
        att_issue(ws, nxt, tid, wave, lane, pre, qpre, bpre, vmask);
        {
            int g, b, h, r, n0, dsh; att_decode(item, g, b, h, r, n0, dsh);
            const int Ls = SEQ >> dsh, tokbase = b * SEQ;
            const int qb = wave >> 2, t = wave & 3, n = n0 + qb, l15 = lane & 15, rg = lane >> 4;
            const int tokq = tokbase + ((64 * n + 16 * t + l15) << dsh) + r;
            f32x4 S[9];
            const LAS unsigned char* kb = ks + (64 * qb + 16 * t + l15) * KPITCH + 16 * rg;
            bf16x8 kfa[9], kfb[9];
#pragma unroll
            for (int kt = 0; kt < 9; ++kt) { S[kt] = (f32x4){0.f, 0.f, 0.f, 0.f}; kfa[kt] = *(const LAS bf16x8*)(kb + (16 * kt) * KPITCH); }
#pragma unroll
            for (int kk = 0; kk < 4; ++kk) {
                if (kk < 3) {
#pragma unroll
                    for (int kt = 0; kt < 9; ++kt) { if (kk & 1) kfa[kt] = *(const LAS bf16x8*)(kb + (16 * kt) * KPITCH + 64 * (kk + 1)); else kfb[kt] = *(const LAS bf16x8*)(kb + (16 * kt) * KPITCH + 64 * (kk + 1)); } }
#pragma unroll
                for (int kt = 0; kt < 9; ++kt) S[kt] = __builtin_amdgcn_mfma_f32_16x16x32_bf16((kk & 1) ? kfb[kt] : kfa[kt], qf[kk], S[kt], 0, 0, 0);
            }
            float mx = -3.0e38f;
            const int idxk0 = 64 * (n - 1) + 16 * t + 4 * rg;
            const LAS float* tb = btab + (4 * rg - l15 + 15);
#pragma unroll
            for (int kt = 0; kt < 9; ++kt)
#pragma unroll
                for (int j = 0; j < 4; ++j) { const int idxk = idxk0 + 16 * kt + j;
                    const float pen = (idxk >= 0 && idxk < Ls) ? 0.f : -1.0e30f;
                    const float sv = fmaxf((S[kt][j] + tb[16 * kt + j]) + pen, -1.0e30f);
                    S[kt][j] = sv; mx = fmaxf(mx, sv); }
            mx = fmaxf(mx, __shfl_xor(mx, 16)); mx = fmaxf(mx, __shfl_xor(mx, 32));
            float lsum = 0.f; bf16x8 pf[5];
#pragma unroll
            for (int ksx = 0; ksx < 5; ++ksx) { float e[8];
#pragma unroll
                for (int j = 0; j < 4; ++j) { e[j] = __expf(S[2 * ksx][j] - mx); e[4 + j] = (2 * ksx + 1 < 9) ? __expf(S[(2 * ksx + 1 < 9) ? 2 * ksx + 1 : 8][j] - mx) : 0.f; }
#pragma unroll
                for (int j = 0; j < 8; ++j) lsum += e[j];
                u32x4 w; w.x = cvt_pk_bf16(e[0], e[1]); w.y = cvt_pk_bf16(e[2], e[3]); w.z = cvt_pk_bf16(e[4], e[5]); w.w = cvt_pk_bf16(e[6], e[7]);
                pf[ksx] = __builtin_bit_cast(bf16x8, w); }
            lsum += __shfl_xor(lsum, 16); lsum += __shfl_xor(lsum, 32);
            f32x4 O[8];
#pragma unroll
            for (int ct = 0; ct < 8; ++ct) O[ct] = (f32x4){0.f, 0.f, 0.f, 0.f};
            const LAS unsigned char* vb = vs + (64 * qb + 16 * t + 4 * rg + (l15 >> 2)) * VPITCH + 64 * (lane & 3);
#pragma unroll
            for (int ksx = 0; ksx < 5; ++ksx)
#pragma unroll
                for (int ct = 0; ct < 8; ++ct) {
                    const s16x4 lo = __builtin_amdgcn_ds_read_tr16_b64_v4i16((LAS s16x4*)(vb + (32 * ksx) * VPITCH + 8 * ct));
                    const s16x4 hi = __builtin_amdgcn_ds_read_tr16_b64_v4i16((LAS s16x4*)(vb + (32 * ksx + 16) * VPITCH + 8 * ct));
                    const bf16x8 vf = __builtin_shufflevector(lo, hi, 0, 1, 2, 3, 4, 5, 6, 7);
                    O[ct] = __builtin_amdgcn_mfma_f32_16x16x32_bf16(vf, pf[ksx], O[ct], 0, 0, 0); }
            bf16_t* op = (bf16_t*)(ws + WS_OG) + ((size_t)g * MTOK + tokq) * AW + h * 128 + 32 * rg; const float inv = 1.0f / lsum;
#pragma unroll
            for (int c2 = 0; c2 < 4; ++c2) { const f32x4 o0 = O[2 * c2] * inv, o1 = O[2 * c2 + 1] * inv;
                u32x4 w; w.x = cvt_pk_bf16(o0[0], o0[1]); w.y = cvt_pk_bf16(o0[2], o0[3]); w.z = cvt_pk_bf16(o1[0], o1[1]); w.w = cvt_pk_bf16(o1[2], o1[3]); *(u32x4*)(op + 8 * c2) = w; }
            ((float*)(ws + WS_LSE))[((size_t)g * MTOK + tokq) * 8 + h] = mx + __logf(lsum);
        }
        asm volatile("s_waitcnt lgkmcnt(0)" ::: "memory"); __builtin_amdgcn_s_barrier(); asm volatile("" ::: "memory");
}
__device__ __forceinline__ void attn_phase(const Args& A, LAS unsigned char* lds) {
    const int tid = threadIdx.x, lane = tid & 63, wave = __builtin_amdgcn_readfirstlane(tid >> 6), G = gridDim.x;
    unsigned char* ws = A.ws;
    LAS unsigned char* ks = lds; LAS unsigned char* vs = lds + AT_VS; LAS float* btab = (LAS float*)(lds + AT_BT);
    if (tid < 288) *(LAS u32x4*)(vs + 256 * VPITCH + tid * 16) = (u32x4){0u, 0u, 0u, 0u};
    u32x4 pre[16]; bf16x8 qpre[4]; float bpre; unsigned vmask;
    const bool xmap = (G == 256);
    const int per = xmap ? 24 : (ATT_ITEMS + G - 1) / G;
    const int ibase = blockIdx.x * per, nit = xmap ? 24 : ((ibase + per) < ATT_ITEMS ? per : (ATT_ITEMS - ibase > 0 ? ATT_ITEMS - ibase : 0));
#define ATT_MAP(i) (xmap ? (((((3 * (int)(blockIdx.x >> 3) + (i) % 3) >> 5) << 11) | (((int)(blockIdx.x & 7) + 8 * ((i) / 3)) << 5) | ((3 * (int)(blockIdx.x >> 3) + (i) % 3) & 31))) : (ibase + (i)))
    if (nit > 0) {
        int item = ATT_MAP(0);
        att_issue(ws, item, tid, wave, lane, pre, qpre, bpre, vmask);
        { const int nxt = ATT_MAP(1 < nit ? 1 : 0); att_body(ws, ks, vs, btab, item, nxt, tid, wave, lane, pre, qpre, bpre, vmask); item = nxt; }
        for (int ii = 1; ii < nit; ++ii) { const int nxt = ATT_MAP(ii + 1 < nit ? ii + 1 : ii); att_body(ws, ks, vs, btab, item, nxt, tid, wave, lane, pre, qpre, bpre, vmask); item = nxt; }
    }
#undef ATT_MAP
    __syncthreads();
}

__device__ __forceinline__ float bf_el(u32x2 r, int ch) { return ch == 0 ? bf_lo(r.x) : (ch == 1 ? bf_hi(r.x) : (ch == 2 ? bf_lo(r.y) : bf_hi(r.y))); }
__device__ __forceinline__ void sconv_phase(const Args& A) {
    const int tid = threadIdx.x, lane = tid & 63, wave = tid >> 6, gw = blockIdx.x * 8 + wave, NGW = gridDim.x * 8; unsigned char* ws = A.ws;
    const bf16_t* HY = (const bf16_t*)(ws + WS_HY); const float* cw = A.in[7]; const float* cb = A.in[8];
    bf16_t* zt = (bf16_t*)(ws + WS_ZT); bf16_t* x0t = (bf16_t*)(ws + WS_X0T);
    const int b = lane >> 3, cgp = lane & 7;
    const bool xmap = (gridDim.x == 256);
    const int wid = (int)(blockIdx.x >> 3) * 8 + wave;
    for (int it = 0; it < (xmap ? 8 : (32 * 512 + NGW - 1) / NGW); ++it) {
        const int id = xmap ? ((8 * ((int)(blockIdx.x & 7) + 8 * it) + (wid >> 5)) * 32 + (wid & 31)) : (gw + NGW * it);
        if (id >= 32 * 512) break;
        const int ct = id & 31, q = id >> 5, c0 = 32 * ct + 4 * cgp, j0 = 8 * q;
        f32x4 w[3][3], bs[3];
#pragma unroll
        for (int s = 0; s < 3; ++s) { bs[s] = *(const f32x4*)(cb + s * 1024 + c0);
#pragma unroll
            for (int t = 0; t < 3; ++t) w[s][t] = *(const f32x4*)(cw + t * 3072 + s * 1024 + c0); }
        u32x2 rows[10][3];
#pragma unroll
        for (int rr = 0; rr < 10; ++rr) { const int js = j0 - 1 + rr; const bool ok = js >= 0 && js < SEQ; const bf16_t* rp = HY + (size_t)(b * SEQ + (ok ? js : 0)) * 3072 + c0;
#pragma unroll
            for (int s = 0; s < 3; ++s) { u32x2 v = *(const u32x2*)(rp + s * 1024); if (!ok) v = (u32x2){0u, 0u}; rows[rr][s] = v; } }
        unsigned ox[4][4], oz[4][4]; float px[4], pz[4];
#pragma unroll
        for (int jj = 0; jj < 8; ++jj) {
#pragma unroll
            for (int ch = 0; ch < 4; ++ch) { float v[3];
#pragma unroll
                for (int s = 0; s < 3; ++s) v[s] = bs[s][ch] + w[s][0][ch] * bf_el(rows[jj][s], ch) + w[s][1][ch] * bf_el(rows[jj + 1][s], ch) + w[s][2][ch] * bf_el(rows[jj + 2][s], ch);
                const float x0 = v[0], z = v[2] * v[1];
                if (jj & 1) { ox[ch][jj >> 1] = cvt_pk_bf16(px[ch], x0); oz[ch][jj >> 1] = cvt_pk_bf16(pz[ch], z); } else { px[ch] = x0; pz[ch] = z; } } }
#pragma unroll
        for (int ch = 0; ch < 4; ++ch) { const size_t dst = ((size_t)(c0 + ch) * 512 + q) * 64 + b * 8;
            *(u32x4*)(x0t + dst) = (u32x4){ox[ch][0], ox[ch][1], ox[ch][2], ox[ch][3]}; *(u32x4*)(zt + dst) = (u32x4){oz[ch][0], oz[ch][1], oz[ch][2], oz[ch][3]}; }
    }
}

__device__ __forceinline__ void lconv_item(const Args& A, LAS unsigned char* lds, int c) {
    const int tid = threadIdx.x, lane = tid & 63, wave = __builtin_amdgcn_readfirstlane(tid >> 6); unsigned char* ws = A.ws;
    LAS unsigned char* zs = lds; LAS unsigned char* hA = lds + 70144; LAS unsigned char* hB = hA + 16640;
    { const u32x4* zsrc = (const u32x4*)((const bf16_t*)(ws + WS_ZT) + (size_t)c * 32768);
        for (int ch = tid; ch < 4096; ch += 512) *(LAS u32x4*)(zs + 256 + ch * 16) = zsrc[ch];
        if (tid < 16) *(LAS u32x4*)(zs + tid * 16) = (u32x4){0u, 0u, 0u, 0u};
        if (tid >= 64 && tid < 336) *(LAS u32x4*)(zs + 65792 + (tid - 64) * 16) = (u32x4){0u, 0u, 0u, 0u};
        const u32x4* hsrc = (const u32x4*)((const bf16_t*)(ws + WS_HR) + (size_t)c * HRLEN);
        for (int ch = tid; ch < 1040; ch += 512) *(LAS u32x4*)(hA + ch * 16) = hsrc[ch]; }
    __syncthreads();
    for (int k = tid; k < 4160; k += 512) { const unsigned lo = ((const LAS unsigned*)hA)[k], hi = (k + 1 < 4160) ? ((const LAS unsigned*)hA)[k + 1] : 0u; ((LAS unsigned*)hB)[k] = (lo >> 16) | (hi << 16); }
    __syncthreads();
    {
        const int m = lane & 15, gq = lane >> 4;
        const LAS unsigned char* tbase = ((m & 1) ? (hB - 2) : hA) + 2 * (4144 + 8 * gq - m);
        const int bb = m & 7, sh = m >> 3;
        const LAS unsigned char* zbase = zs + ((2 * sh + gq) * 8 + bb) * 16;
        const bf16_t* x0t = (const bf16_t*)(ws + WS_X0T) + (size_t)c * 32768; bf16_t* yt = (bf16_t*)(ws + WS_YT) + (size_t)c * 32768;
#pragma unroll 1
        for (int ib = 0; ib < 2; ++ib) {
            const int It0 = 16 * wave + 8 * ib;
            const int jlo = (It0 - 64) > 0 ? (It0 - 64) : 0, jhi = (It0 + 71) < 128 ? (It0 + 71) : 128;
            const int elo = jlo - It0, nch = (jhi - jlo + 8) >> 3;
            const LAS unsigned char* tp = tbase + 64 * elo; const LAS unsigned char* zp = zbase + 512 * jlo;
            f32x4 acc[8]; bf16x8 R[8];
#pragma unroll
            for (int p = 0; p < 8; ++p) acc[p] = (f32x4){0.f, 0.f, 0.f, 0.f};
            R[0] = (bf16x8){0, 0, 0, 0, 0, 0, 0, 0};
#pragma unroll
            for (int k = 1; k < 8; ++k) R[k] = __builtin_bit_cast(bf16x8, *(const LAS u32x4_a4*)(tp + 64 * (k - 8)));
#pragma unroll 1
            for (int chn = 0; chn < nch; ++chn) {
#pragma unroll
                for (int k = 0; k < 8; ++k) {
                    R[k] = __builtin_bit_cast(bf16x8, *(const LAS u32x4_a4*)(tp + 64 * k));
                    const bf16x8 zf = *(const LAS bf16x8*)(zp + 512 * k);
#pragma unroll
                    for (int p = 0; p < 8; ++p) acc[p] = __builtin_amdgcn_mfma_f32_16x16x32_bf16(R[(k - p) & 7], zf, acc[p], 0, 0, 0); }
                tp += 512; zp += 4096; }
#pragma unroll
            for (int p = 0; p < 8; ++p) { const int q = 4 * (It0 + p) + 2 * sh + (gq >> 1); const size_t off = (size_t)(q * 8 + bb) * 8 + 4 * (gq & 1);
                const u32x2 xw = *(const u32x2*)(x0t + off);
                u32x2 w; w.x = cvt_pk_bf16(acc[p][0] * bf_lo(xw.x), acc[p][1] * bf_hi(xw.x)); w.y = cvt_pk_bf16(acc[p][2] * bf_lo(xw.y), acc[p][3] * bf_hi(xw.y));
                *(u32x2*)(yt + off) = w; }
        }
    }
    __syncthreads();
}

__device__ __forceinline__ void merge_attn(const Args& A) {
    const int tid = threadIdx.x, lane = tid & 63, wave = tid >> 6, gw = blockIdx.x * 8 + wave, NGW = gridDim.x * 8; unsigned char* ws = A.ws;
    const bf16_t* og = (const bf16_t*)(ws + WS_OG); const float* lse = (const float*)(ws + WS_LSE); bf16_t* y = (bf16_t*)(ws + WS_Y); const float* gain = A.in[17];
    const int head = lane >> 3, col = lane * 16;
    f32x4 gn[4];
#pragma unroll
    for (int k = 0; k < 4; ++k) gn[k] = *(const f32x4*)(gain + col + 4 * k);
    for (int tok = gw; tok < MTOK; tok += NGW) {
        float l[3], mxl = -3.0e38f;
#pragma unroll
        for (int g = 0; g < 3; ++g) { l[g] = lse[((size_t)g * MTOK + tok) * 8 + head]; mxl = fmaxf(mxl, l[g]); }
        float wsum = 0.f;
#pragma unroll
        for (int g = 0; g < 3; ++g) { l[g] = __expf(l[g] - mxl); wsum += l[g]; }
        const float iw = 1.0f / wsum; float v[16];
#pragma unroll
        for (int k = 0; k < 16; ++k) v[k] = 0.f;
#pragma unroll
        for (int g = 0; g < 3; ++g) { const float wg = l[g] * iw; const u32x4* src = (const u32x4*)(og + ((size_t)g * MTOK + tok) * AW + col);
#pragma unroll
            for (int k = 0; k < 2; ++k) { const u32x4 t = src[k];
                v[8 * k + 0] += wg * bf_lo(t.x); v[8 * k + 1] += wg * bf_hi(t.x); v[8 * k + 2] += wg * bf_lo(t.y); v[8 * k + 3] += wg * bf_hi(t.y);
                v[8 * k + 4] += wg * bf_lo(t.z); v[8 * k + 5] += wg * bf_hi(t.z); v[8 * k + 6] += wg * bf_lo(t.w); v[8 * k + 7] += wg * bf_hi(t.w); } }
        float ss = 0.f;
#pragma unroll
        for (int k = 0; k < 16; ++k) ss += v[k] * v[k];
        ss += __shfl_xor(ss, 1); ss += __shfl_xor(ss, 2); ss += __shfl_xor(ss, 4);
        const float r = 1.0f / sqrtf(ss * (1.0f / 128.0f) + EPS);
        u32x4 o0, o1;
        o0.x = cvt_pk_bf16(v[0] * r * gn[0][0], v[1] * r * gn[0][1]); o0.y = cvt_pk_bf16(v[2] * r * gn[0][2], v[3] * r * gn[0][3]);
        o0.z = cvt_pk_bf16(v[4] * r * gn[1][0], v[5] * r * gn[1][1]); o0.w = cvt_pk_bf16(v[6] * r * gn[1][2], v[7] * r * gn[1][3]);
        o1.x = cvt_pk_bf16(v[8] * r * gn[2][0], v[9] * r * gn[2][1]); o1.y = cvt_pk_bf16(v[10] * r * gn[2][2], v[11] * r * gn[2][3]);
        o1.z = cvt_pk_bf16(v[12] * r * gn[3][0], v[13] * r * gn[3][1]); o1.w = cvt_pk_bf16(v[14] * r * gn[3][2], v[15] * r * gn[3][3]);
        u32x4* dst = (u32x4*)(y + (size_t)tok * DM + col); dst[0] = o0; dst[1] = o1;
    }
}
__device__ __forceinline__ void hynorm_item(const Args& A, LAS unsigned char* lds, int item) {
    const int tid = threadIdx.x; unsigned char* ws = A.ws;
    const int grp = item >> 9, q = item & 511;
    LAS float* t = (LAS float*)lds;
    { const int c = tid >> 2, part = tid & 3; const u32x4* src = (const u32x4*)((const bf16_t*)(ws + WS_YT) + ((size_t)(grp * 128 + c) * 512 + q) * 64 + part * 16);
#pragma unroll
        for (int k = 0; k < 2; ++k) { const u32x4 v = src[k]; LAS float* d = t + c * 65 + part * 16 + 8 * k;
            d[0] = bf_lo(v.x); d[1] = bf_hi(v.x); d[2] = bf_lo(v.y); d[3] = bf_hi(v.y); d[4] = bf_lo(v.z); d[5] = bf_hi(v.z); d[6] = bf_lo(v.w); d[7] = bf_hi(v.w); } }
    __syncthreads();
    { const int pos = tid >> 3, p8 = tid & 7; float v[16], ss = 0.f;
#pragma unroll
        for (int k = 0; k < 16; ++k) { v[k] = t[(p8 * 16 + k) * 65 + pos]; ss += v[k] * v[k]; }
        ss += __shfl_xor(ss, 1); ss += __shfl_xor(ss, 2); ss += __shfl_xor(ss, 4);
        const float r = 1.0f / sqrtf(ss * (1.0f / 128.0f) + EPS); const float* gp = A.in[18] + grp * 128 + p8 * 16;
        unsigned w[8];
#pragma unroll
        for (int k = 0; k < 8; ++k) w[k] = cvt_pk_bf16(v[2 * k] * r * gp[2 * k], v[2 * k + 1] * r * gp[2 * k + 1]);
        const int b = pos >> 3, i8 = pos & 7; bf16_t* dst = (bf16_t*)(ws + WS_Y) + (size_t)(b * SEQ + 8 * q + i8) * DM + 1024 + grp * 128 + p8 * 16;
        ((u32x4*)dst)[0] = (u32x4){w[0], w[1], w[2], w[3]}; ((u32x4*)dst)[1] = (u32x4){w[4], w[5], w[6], w[7]}; }
    __syncthreads();
}

#define XB_TMO      128
#define XB_XCNT(j)  (256  + 64 * (j))
#define XB_XSUB(j)  (1280 + 64 * (j))
#define XB_XGEN(j)  (2304 + 64 * (j))
#define XB_TOP      3328
#define XB_TOPGEN   3392
#define XCD_BAR_WORDS 3456
#define XB_SPIN_CAP (1u << 18)
__device__ __forceinline__ unsigned xb_ld(unsigned* p)              { return __hip_atomic_load(p, __ATOMIC_RELAXED, __HIP_MEMORY_SCOPE_AGENT); }
__device__ __forceinline__ unsigned xb_add(unsigned* p, unsigned v) { return __hip_atomic_fetch_add(p, v, __ATOMIC_RELAXED, __HIP_MEMORY_SCOPE_AGENT); }
__device__ __forceinline__ unsigned xb_xcc_id() { return (unsigned)__builtin_amdgcn_s_getreg((3 << 11) | 20) & 0xFu; }
#define XB_SPIN(cond, bar) do { unsigned _sp = 0; while (cond) { __builtin_amdgcn_s_sleep(1); \
    if ((++_sp & 255u) == 0u) { if (xb_ld(&(bar)[XB_TMO])) break; if (_sp > XB_SPIN_CAP) { atomicAdd(&(bar)[XB_TMO], 1u); break; } } } } while (0)
struct XcdBarrier { unsigned* bar; unsigned x; volatile LAS unsigned* st; };
__device__ __forceinline__ XcdBarrier xcd_barrier_post(unsigned* bar, volatile LAS unsigned* st) {
    XcdBarrier b; b.bar = bar; b.x = xb_xcc_id(); b.st = st;
    if (threadIdx.x == 0) (void)xb_add(&bar[XB_XCNT(b.x)], 1u);
    return b;
}
__device__ __forceinline__ void xcd_barrier_complete(unsigned* bar, unsigned x, unsigned& nloc, unsigned& nx) {
    const unsigned G = gridDim.x * gridDim.y * gridDim.z;
    unsigned sum, cnt, mine, sp = 0u;
    for (;;) {
        sum = 0u; cnt = 0u; mine = 0u;
#pragma unroll
        for (unsigned j = 0; j < 16; ++j) { const unsigned c = xb_ld(&bar[XB_XCNT(j)]); sum += c; cnt += (c > 0u) ? 1u : 0u; mine = (j == x) ? c : mine; }
        if (sum == G) break;
        __builtin_amdgcn_s_sleep(1);
        if ((++sp & 255u) == 0u) { if (xb_ld(&bar[XB_TMO])) break; if (sp > XB_SPIN_CAP) { atomicAdd(&bar[XB_TMO], 1u); break; } }
    }
    nloc = mine > 0u ? mine : 1u; nx = cnt > 0u ? cnt : 1u;
}
__device__ __forceinline__ void xcd_barrier(const XcdBarrier& b) {
    asm volatile("s_waitcnt vmcnt(0)" ::: "memory");
    __syncthreads();
    if (threadIdx.x == 0) {
        unsigned* bar = b.bar;
        __builtin_amdgcn_s_waitcnt(0);
        unsigned nloc = b.st[0], nx = b.st[1];
        if (nloc == 0u) { xcd_barrier_complete(bar, b.x, nloc, nx); b.st[0] = nloc; b.st[1] = nx; }
        const unsigned old = xb_add(&bar[XB_XSUB(b.x)], 1u);
        const unsigned gen = old / nloc;
        if (old + 1u == (gen + 1u) * nloc) {
            __builtin_amdgcn_fence(__ATOMIC_RELEASE, "agent");
            asm volatile("s_waitcnt vmcnt(0)" ::: "memory");
            const unsigned og = xb_add(&bar[XB_TOP], 1u);
            const unsigned tg = og / nx;
            if (og + 1u == (tg + 1u) * nx) xb_add(&bar[XB_TOPGEN], 1u);
            else XB_SPIN(xb_ld(&bar[XB_TOPGEN]) == tg, bar);
            __builtin_amdgcn_fence(__ATOMIC_ACQUIRE, "agent");
            xb_add(&bar[XB_XGEN(b.x)], 1u);
            asm volatile("s_waitcnt vmcnt(0)" ::: "memory");
        } else {
            XB_SPIN(xb_ld(&bar[XB_XGEN(b.x)]) == gen, bar);
            __builtin_amdgcn_fence(__ATOMIC_ACQUIRE, "agent");
            asm volatile("s_waitcnt vmcnt(0)" ::: "memory");
        }
    }
    __syncthreads();
}

__global__ void __launch_bounds__(512, 2) fwd_mega(Args args) {
    extern __shared__ __attribute__((aligned(16))) unsigned char lds_raw[];
    LAS unsigned char* lds = (LAS unsigned char*)lds_raw;
    LAS float* xl = (LAS float*)(lds + XL_OFF);
    const int lo = args.ph_lo, hi = args.ph_hi, G = gridDim.x;
    unsigned char* ws = args.ws;
    volatile LAS unsigned* bst = (volatile LAS unsigned*)(lds + BARST_OFF);
    if (threadIdx.x < 2) bst[threadIdx.x] = 0u;
    __syncthreads();
    XcdBarrier xbar; xbar.bar = (unsigned*)(ws + WS_BAR); xbar.x = 0; xbar.st = bst;
    if (args.ph_lo > 0) xbar = xcd_barrier_post((unsigned*)(ws + WS_BAR), bst);
#ifndef DUPMASK
#define DUPMASK 0
#endif
#define IN(k) (lo <= (k) && (k) < hi)
#define REP(k) for (int rep_ = 0; rep_ < (((DUPMASK >> (k)) & 1) ? 2 : 1); ++rep_, (rep_ < 2 && ((DUPMASK >> (k)) & 1)) ? cg::this_grid().sync() : (void)0)
#define SEAM(k) do { if (IN(k) && IN((k) + 1)) { if ((k) == 0) cg::this_grid().sync(); else xcd_barrier(xbar); } } while (0)
    if (IN(0)) REP(0) { p0_prologue(args, lds); } SEAM(0);
    if (args.ph_lo == 0) xbar = xcd_barrier_post((unsigned*)(ws + WS_BAR), bst);
    if (IN(1)) { pg8::Gemm g{(const bf16_t*)(ws + WS_XB), (const bf16_t*)(ws + WS_WIN), MTOK, INW, DM}; pg8::StaticOrder S; S.init(MTOK, INW, G, (int)blockIdx.x);
        EpiIn E{ws, args.in[5], args.in[6]}; pg8::gemm_phase(lds, xl, g, S, E); } SEAM(1);
    if (IN(2)) REP(2) { attn_phase(args, lds);
        sconv_phase(args); } SEAM(2);
    if (IN(3)) REP(3) { for (int c = blockIdx.x; c < HW; c += G) lconv_item(args, lds, c); } SEAM(3);
    if (IN(4)) REP(4) { merge_attn(args); for (int it = blockIdx.x; it < 4096; it += G) hynorm_item(args, lds, it); } SEAM(4);
    if (IN(5)) { { pg8::Gemm g{(const bf16_t*)(ws + WS_Y), (const bf16_t*)(ws + WS_WOUT), MTOK, DM, DM}; pg8::StaticOrder S; S.init(MTOK, DM, G, (int)blockIdx.x);
            EpiOut E{args.in[0], (bf16_t*)(ws + WS_H1B), (float*)(ws + WS_SS1)}; pg8::gemm_phase(lds, xl, g, S, E); }
        { pg8::Gemm g{(const bf16_t*)(ws + WS_PB), (const bf16_t*)(ws + WS_WPROJ), MTOK, DM, PLE}; pg8::StaticOrder S; S.init(MTOK, DM, G, (int)blockIdx.x);
            EpiProj E{(bf16_t*)(ws + WS_ERAW), (float*)(ws + WS_SSE)}; pg8::gemm_phase(lds, xl, g, S, E); } } SEAM(5);
    if (IN(6)) { pg8::Gemm g{(const bf16_t*)(ws + WS_H1B), (const bf16_t*)(ws + WS_WGU), MTOK, 2 * FF, DM}; pg8::StaticOrder S; S.init(MTOK, 2 * FF, G, (int)blockIdx.x);
        EpiGU E{(bf16_t*)(ws + WS_ACT), (const float*)(ws + WS_SS1)}; pg8::gemm_phase(lds, xl, g, S, E); } SEAM(6);
    if (IN(7)) { pg8::Gemm g{(const bf16_t*)(ws + WS_ACT), (const bf16_t*)(ws + WS_WDOWN), MTOK, DM, FF}; pg8::StaticOrder S; S.init(MTOK, DM, G, (int)blockIdx.x);
        EpiDown E{(const bf16_t*)(ws + WS_H1B), (bf16_t*)(ws + WS_H2B), (float*)(ws + WS_SS2)}; pg8::gemm_phase(lds, xl, g, S, E); } SEAM(7);
    if (IN(8)) { pg8::Gemm g{(const bf16_t*)(ws + WS_H2B), (const bf16_t*)(ws + WS_WGATE), MTOK, DM, DM}; pg8::StaticOrder S; S.init(MTOK, DM, G, (int)blockIdx.x);
        EpiGate E{args.out, (const bf16_t*)(ws + WS_H2B), (const bf16_t*)(ws + WS_ERAW), (const float*)(ws + WS_SS2), (const float*)(ws + WS_SSE), args.in[26]}; pg8::gemm_phase(lds, xl, g, S, E); }
#undef IN
#undef SEAM
}

extern "C" void kernel_launch(void* const* d_in, const int* in_sizes, int n_in, void* d_out, int out_size, void* d_ws, size_t ws_size, hipStream_t stream) {
    static int grid = 0;
    if (grid == 0) {
        if (n_in != 27 || out_size != MTOK * DM || ws_size < WS_END) { fprintf(stderr, "kernel_launch: unexpected shapes (n_in %d out %d ws %zu)\n", n_in, out_size, ws_size); grid = -1; return; }
        int dev = 0, cus = 0, per_cu = 0;
        (void)hipGetDevice(&dev); (void)hipDeviceGetAttribute(&cus, hipDeviceAttributeMultiprocessorCount, dev);
        if (hipFuncSetAttribute((const void*)fwd_mega, hipFuncAttributeMaxDynamicSharedMemorySize, LDS_BYTES) != hipSuccess) { fprintf(stderr, "kernel_launch: hipFuncSetAttribute failed\n"); grid = -1; return; }
        if (hipOccupancyMaxActiveBlocksPerMultiprocessor(&per_cu, (const void*)fwd_mega, 512, LDS_BYTES) != hipSuccess || per_cu < 1) { fprintf(stderr, "kernel_launch: occupancy query says %d\n", per_cu); per_cu = 1; }
        (void)hipGetLastError();
        grid = cus * per_cu;
    }
    if (grid < 0) return;
    Args a{};
    for (int i = 0; i < 27; ++i) a.in[i] = (const float*)d_in[i];
    a.out = (float*)d_out; a.ws = (unsigned char*)d_ws;
#if ONE_LAUNCH
    a.ph_lo = 0; a.ph_hi = NPH;
    void* kargs[] = {&a};
    hipError_t e = hipLaunchCooperativeKernel((const void*)fwd_mega, dim3(grid), dim3(512), kargs, LDS_BYTES, stream);
    if (e != hipSuccess) fprintf(stderr, "kernel_launch: cooperative launch failed: %s (grid %d)\n", hipGetErrorString(e), grid);
#else
    for (int ph = 0; ph < NPH; ++ph) { a.ph_lo = ph; a.ph_hi = ph + 1; hipLaunchKernelGGL(fwd_mega, dim3(grid), dim3(512), LDS_BYTES, stream, a); }
#endif
}
```

```cpp
#include <hip/hip_runtime.h>
#include <hip/hip_cooperative_groups.h>
#include <cstdio>
#include <cstdint>
namespace cg = cooperative_groups;

#ifndef ONE_LAUNCH
#define ONE_LAUNCH 1
#endif

#define LAS __attribute__((address_space(3)))
typedef unsigned short bf16_t;
typedef short bf16x8 __attribute__((ext_vector_type(8)));
typedef short s16x4 __attribute__((ext_vector_type(4)));
typedef float f32x4 __attribute__((ext_vector_type(4)));
typedef unsigned u32x4 __attribute__((ext_vector_type(4)));
typedef unsigned u32x2 __attribute__((ext_vector_type(2)));
typedef u32x4 u32x4_a4 __attribute__((aligned(4)));

__device__ __forceinline__ unsigned cvt_pk_bf16(float lo, float hi) { unsigned r; asm volatile("v_cvt_pk_bf16_f32 %0, %1, %2" : "=v"(r) : "v"(lo), "v"(hi)); return r; }
__device__ __forceinline__ float bf_lo(unsigned w) { return __uint_as_float(w << 16); }
__device__ __forceinline__ float bf_hi(unsigned w) { return __uint_as_float(w & 0xffff0000u); }
__device__ __forceinline__ float dot4(f32x4 a) { return (a[0] * a[0] + a[1] * a[1]) + (a[2] * a[2] + a[3] * a[3]); }

namespace pg8 {
#define PG8_LAS __attribute__((address_space(3)))
constexpr int BM = 256, BK = 64, HALF = 128, HTB = HALF * BK * 2, STAGE_BYTES = 8 * HTB, NXCD = 8, WGM = 8;
__host__ __device__ __forceinline__ int lds_byte(int r, int c) { const int st = (r >> 4) * 2 + (c >> 5), rr = r & 15, cc = c & 31, ob = rr * 64 + cc * 2; return st * 1024 + (ob ^ (((ob >> 9) & 1) << 5)); }
__host__ __device__ __forceinline__ void stage_rc(int b, int& R, int& C) { const int st = b / 1024, sb = b % 1024, swz = sb ^ (((sb >> 9) & 1) << 5); R = (st >> 1) * 16 + swz / 64; C = (st & 1) * 32 + (swz % 64) / 2; }
__host__ __device__ __forceinline__ int perm32(int rho) { const int n = rho >> 4, i = rho & 15; return 8 * (i >> 2) + 4 * n + (i & 3); }
struct Unit { int pm, pn; };
struct Gemm { const bf16_t* A; const bf16_t* Bt; int M, N, K; };
struct StaticOrder {
    int nM, nN, nwg, G, c;
    __host__ __device__ void init(int M, int N, int G_, int c_) { nM = M / BM; nN = N / BM; nwg = nM * nN; G = G_; c = c_; }
    __host__ __device__ bool next(int i, Unit& u) const {
        const long L = (long)i * G + c; if (L >= nwg) return false;
        int wgid = (int)L; { const int q = nwg / NXCD, r = nwg % NXCD, xcd = wgid % NXCD, off = wgid / NXCD; wgid = (xcd < r ? xcd * (q + 1) : r * (q + 1) + (xcd - r) * q) + off; }
        const int nig = WGM * nN, gid = wgid / nig, fm = gid * WGM, gsz = (nM - fm) < WGM ? (nM - fm) : WGM;
        u.pm = fm + ((wgid % nig) % gsz); u.pn = (wgid % nig) / gsz; return true;
    }
};
template <class Epi>
__device__ __forceinline__ void gemm_phase(PG8_LAS unsigned char* lds, PG8_LAS float* xl, const Gemm g, const StaticOrder& S, const Epi& E) {
    const int tid = threadIdx.x, wid = __builtin_amdgcn_readfirstlane(tid >> 6), lane = tid & 63, wr = wid >> 2, wc = wid & 3, fr = lane & 15, fq = lane >> 4;
    const int K = g.K, nt = K / BK;
    unsigned voffA[2], voffB[2];
#pragma unroll
    for (int i = 0; i < 2; ++i) { int R, C; stage_rc(tid * 16 + i * 8192, R, C); const int Rb = (R & ~31) + perm32(R & 31);
        voffA[i] = (unsigned)(R * K + C) * 2u; voffB[i] = (unsigned)(Rb * K + C) * 2u; }
    const size_t kstep = (size_t)(BK * 2);
    const size_t hstep = (size_t)HALF * K * 2;
    const size_t tstep = 2 * hstep;
    const unsigned ldsw = (unsigned)wid * 1024u;
    const int aoff = lds_byte(wr * 64 + fr, fq * 8), boff = lds_byte(wc * 32 + fr, fq * 8);
#define PG8_SA(b, h) (((b) * 2 + (h)) * HTB)
#define PG8_SB(b, h) ((4 + (b) * 2 + (h)) * HTB)
#define PG8_STAGE(bufoff, gbase, voff) do { _Pragma("unroll") for (int _i = 0; _i < 2; ++_i) \
        __builtin_amdgcn_global_load_lds((const unsigned*)((const char*)(gbase) + (voff)[_i]), (PG8_LAS unsigned*)(lds + (bufoff) + ldsw + _i * 8192), 16, 0, 0); } while (0)
#define PG8_LDA(dst, b, h) do { _Pragma("unroll") for (int m = 0; m < 4; ++m) _Pragma("unroll") for (int k = 0; k < 2; ++k) dst[m][k] = *(const PG8_LAS bf16x8*)(lds + PG8_SA(b, h) + aoff + m * 2048 + k * 1024); } while (0)
#define PG8_LDB(dst, b, h) do { _Pragma("unroll") for (int n = 0; n < 2; ++n) _Pragma("unroll") for (int k = 0; k < 2; ++k) dst[n][k] = *(const PG8_LAS bf16x8*)(lds + PG8_SB(b, h) + boff + n * 2048 + k * 1024); } while (0)
#define PG8_MMA(ai, bj, At, Bt) do { __builtin_amdgcn_s_setprio(1); _Pragma("unroll") for (int m = 0; m < 4; ++m) _Pragma("unroll") for (int n = 0; n < 2; ++n) _Pragma("unroll") for (int k = 0; k < 2; ++k) \
        acc[ai][bj][m][n] = __builtin_amdgcn_mfma_f32_16x16x32_bf16(Bt[n][k], At[m][k], acc[ai][bj][m][n], 0, 0, 0); __builtin_amdgcn_s_setprio(0); } while (0)
#define PG8_WAIT_V(n) asm volatile("s_waitcnt vmcnt(" #n ")" ::: "memory")
#define PG8_WAIT_L(n) asm volatile("s_waitcnt lgkmcnt(" #n ")" ::: "memory")
#define PG8_BAR __builtin_amdgcn_s_barrier()
#define PG8_SCHED __builtin_amdgcn_sched_barrier(0)
    Unit cur, nxt; int ui = 0;
    if (!S.next(0, cur)) return;
    f32x4 acc[2][2][4][2];
#pragma unroll
    for (int a = 0; a < 2; ++a)
#pragma unroll
        for (int b = 0; b < 2; ++b)
#pragma unroll
            for (int m = 0; m < 4; ++m)
#pragma unroll
                for (int n = 0; n < 2; ++n) acc[a][b][m][n] = (f32x4){0.f, 0.f, 0.f, 0.f};
    bf16x8 At[4][2], B0[2][2], B1[2][2];
    const char* cA = (const char*)g.A + (size_t)cur.pm * tstep; const char* cB = (const char*)g.Bt + (size_t)cur.pn * tstep;
    PG8_STAGE(PG8_SB(0, 0), cB, voffB); PG8_STAGE(PG8_SB(0, 1), cB + hstep, voffB); PG8_STAGE(PG8_SA(0, 0), cA, voffA); PG8_STAGE(PG8_SA(0, 1), cA + hstep, voffA);
    if (wr == 1) PG8_BAR;
    PG8_WAIT_V(2); PG8_BAR;
    PG8_STAGE(PG8_SB(1, 0), cB + kstep, voffB); PG8_STAGE(PG8_SA(1, 0), cA + kstep, voffA); PG8_STAGE(PG8_SB(1, 1), cB + hstep + kstep, voffB);
    PG8_WAIT_V(6); PG8_BAR;
    for (;;) {
        const bool has_next = S.next(ui + 1, nxt);
        const char* nA = has_next ? (const char*)g.A + (size_t)nxt.pm * tstep : cA; const char* nB = has_next ? (const char*)g.Bt + (size_t)nxt.pn * tstep : cB;
        for (int t = 0; t < nt; t += 2) {
            const bool last = (t == nt - 2);
            const char* a1 = cA + (size_t)(t + 1) * kstep;
            const char* a2 = last ? nA : cA + (size_t)(t + 2) * kstep; const char* b2 = last ? nB : cB + (size_t)(t + 2) * kstep;
            const char* a3 = a2 + kstep; const char* b3 = b2 + kstep;
            PG8_LDB(B0, 0, 0); PG8_LDB(B1, 0, 1); PG8_SCHED; PG8_LDA(At, 0, 0); PG8_STAGE(PG8_SA(1, 1), a1 + hstep, voffA);
            PG8_WAIT_V(8); PG8_WAIT_L(0); PG8_BAR; PG8_MMA(0, 0, At, B0); PG8_MMA(0, 1, At, B1); PG8_BAR; PG8_SCHED;
            PG8_LDA(At, 0, 1); PG8_STAGE(PG8_SB(0, 0), b2, voffB); PG8_STAGE(PG8_SB(0, 1), b2 + hstep, voffB); PG8_STAGE(PG8_SA(0, 0), a2, voffA);
            PG8_WAIT_V(8); PG8_WAIT_L(0); PG8_BAR; PG8_MMA(1, 0, At, B0); PG8_MMA(1, 1, At, B1); PG8_BAR; PG8_SCHED;
            PG8_LDB(B0, 1, 0); PG8_LDB(B1, 1, 1); PG8_SCHED; PG8_LDA(At, 1, 0); PG8_STAGE(PG8_SA(0, 1), a2 + hstep, voffA);
            PG8_WAIT_V(8); PG8_WAIT_L(0); PG8_BAR; PG8_MMA(0, 0, At, B0); PG8_MMA(0, 1, At, B1); PG8_BAR; PG8_SCHED;
            PG8_LDA(At, 1, 1); PG8_STAGE(PG8_SB(1, 0), b3, voffB); PG8_STAGE(PG8_SB(1, 1), b3 + hstep, voffB); PG8_STAGE(PG8_SA(1, 0), a3, voffA);
            PG8_WAIT_V(8); PG8_WAIT_L(0); PG8_BAR; PG8_MMA(1, 0, At, B0); PG8_MMA(1, 1, At, B1); PG8_BAR; PG8_SCHED;
        }
        if (wr == 0) PG8_BAR;
        E(acc, cur, wr, wc, fr, fq, xl);
        if (!has_next) break;
#pragma unroll
        for (int a = 0; a < 2; ++a)
#pragma unroll
            for (int b = 0; b < 2; ++b)
#pragma unroll
                for (int m = 0; m < 4; ++m)
#pragma unroll
                    for (int n = 0; n < 2; ++n) acc[a][b][m][n] = (f32x4){0.f, 0.f, 0.f, 0.f};
        cur = nxt; cA = nA; cB = nB; ++ui;
        if (wr == 1) PG8_BAR;
    }
    PG8_WAIT_V(0);
    PG8_BAR;
#undef PG8_SA
#undef PG8_SB
#undef PG8_STAGE
#undef PG8_LDA
#undef PG8_LDB
#undef PG8_MMA
#undef PG8_WAIT_V
#undef PG8_WAIT_L
#undef PG8_BAR
#undef PG8_SCHED
}
}

constexpr int MTOK = 32768, DM = 2048, SEQ = 4096, NB = 8, INW = 6144, FF = 5632, PLE = 256, AW = 1024, HW = 1024;
constexpr float EPS = 1e-6f;
constexpr size_t MiB = (size_t)1 << 20;
constexpr size_t WS_WIN = 0, WS_WOUT = 24 * MiB, WS_WGU = 32 * MiB, WS_WDOWN = 76 * MiB, WS_WGATE = 98 * MiB, WS_WPROJ = 106 * MiB;
constexpr size_t WS_HR = 107 * MiB;
constexpr size_t WS_SMALL = 124 * MiB;
constexpr size_t WS_RSTDX = WS_SMALL, WS_SSE = WS_SMALL + 128 * 1024, WS_SS1 = WS_SMALL + 256 * 1024, WS_SS2 = WS_SMALL + 384 * 1024, WS_BTAB = WS_SMALL + 512 * 1024, WS_LSE = WS_SMALL + MiB;
constexpr size_t WS_BAR = WS_SMALL + 640 * 1024;
constexpr size_t WS_OG = 128 * MiB, WS_ERAW = 128 * MiB, WS_XB = 256 * MiB, WS_H2B = 256 * MiB, WS_PB = 384 * MiB;
constexpr size_t WS_Q = 400 * MiB, WS_K = 464 * MiB, WS_V = 528 * MiB, WS_YT = 400 * MiB, WS_H1B = 464 * MiB;
constexpr size_t WS_HY = 592 * MiB, WS_Y = 592 * MiB, WS_ACT = 592 * MiB, WS_ZT = 784 * MiB, WS_X0T = 848 * MiB, WS_END = 944 * MiB;
constexpr int HRLEN = 8320, HROFF = 4160;
constexpr int LDS_BYTES = 155648;
constexpr int XL_OFF = 131072, BARST_OFF = LDS_BYTES - 16;
constexpr int NPH = 9;

struct Args { const float* in[27]; float* out; unsigned char* ws; int ph_lo, ph_hi; };

using pg8::Unit;
struct EpiIn {
    unsigned char* ws; const float* qg; const float* kg;
    __device__ __forceinline__ void operator()(const f32x4 (&acc)[2][2][4][2], const Unit& u, int wr, int wc, int fr, int fq, LAS float* P) const {
        const float* rstd = (const float*)(ws + WS_RSTDX);
        const int rowl0 = wr * 64 + fr, row0 = u.pm * 256 + rowl0;
        if (u.pn < 8) {
#pragma unroll
            for (int ai = 0; ai < 2; ++ai)
#pragma unroll
                for (int m = 0; m < 4; ++m) { const float rs = rstd[row0 + ai * 128 + m * 16];
#pragma unroll
                    for (int bj = 0; bj < 2; ++bj) { float s = (dot4(acc[ai][bj][m][0]) + dot4(acc[ai][bj][m][1])) * rs * rs;
                        s += __shfl_xor(s, 16); s += __shfl_xor(s, 32);
                        if (fq == 0) P[((rowl0 + ai * 128 + m * 16) * 2 + bj) * 4 + wc] = s; } }
            asm volatile("s_waitcnt lgkmcnt(0)" ::: "memory"); __builtin_amdgcn_s_barrier(); asm volatile("" ::: "memory");
            const bool isq = u.pn < 4; const float* gp = (isq ? qg : kg) + wc * 32 + fq * 8; const float sc = isq ? 0.08838834764831845f : 1.0f;
            const f32x4 g0 = *(const f32x4*)gp * sc, g1 = *(const f32x4*)(gp + 4) * sc;
            bf16_t* base = (bf16_t*)(ws + (isq ? WS_Q : WS_K)) + (u.pn & 3) * 256 + wc * 32 + fq * 8;
#pragma unroll
            for (int ai = 0; ai < 2; ++ai)
#pragma unroll
                for (int m = 0; m < 4; ++m) { const int rl = rowl0 + ai * 128 + m * 16; const float rs = rstd[row0 + ai * 128 + m * 16];
#pragma unroll
                    for (int bj = 0; bj < 2; ++bj) { const f32x4 pp = *(const LAS f32x4*)(P + (rl * 2 + bj) * 4);
                        const float tot = (pp[0] + pp[1]) + (pp[2] + pp[3]); const float r = rs * __builtin_amdgcn_rsqf(tot * (1.0f / 128.0f) + EPS);
                        const f32x4 v0 = acc[ai][bj][m][0] * r * g0, v1 = acc[ai][bj][m][1] * r * g1;
                        u32x4 w; w.x = cvt_pk_bf16(v0[0], v0[1]); w.y = cvt_pk_bf16(v0[2], v0[3]); w.z = cvt_pk_bf16(v1[0], v1[1]); w.w = cvt_pk_bf16(v1[2], v1[3]);
                        *(u32x4*)(base + (size_t)(u.pm * 256 + rl) * 1024 + bj * 128) = w; } }
        } else {
            const bool isv = u.pn < 12; const int ld = isv ? 1024 : 3072;
            bf16_t* base = (bf16_t*)(ws + (isv ? WS_V : WS_HY)) + (isv ? (u.pn - 8) : (u.pn - 12)) * 256 + wc * 32 + fq * 8;
#pragma unroll
            for (int ai = 0; ai < 2; ++ai)
#pragma unroll
                for (int m = 0; m < 4; ++m) { const int row = row0 + ai * 128 + m * 16; const float rs = rstd[row];
#pragma unroll
                    for (int bj = 0; bj < 2; ++bj) { const f32x4 v0 = acc[ai][bj][m][0] * rs, v1 = acc[ai][bj][m][1] * rs;
                        u32x4 w; w.x = cvt_pk_bf16(v0[0], v0[1]); w.y = cvt_pk_bf16(v0[2], v0[3]); w.z = cvt_pk_bf16(v1[0], v1[1]); w.w = cvt_pk_bf16(v1[2], v1[3]);
                        *(u32x4*)(base + (size_t)row * ld + bj * 128) = w; } }
        }
    }
};
struct EpiOut {
    const float* base; bf16_t* ob; float* ss;
    __device__ __forceinline__ void operator()(const f32x4 (&acc)[2][2][4][2], const Unit& u, int wr, int wc, int fr, int fq, LAS float*) const {
        const int row0 = u.pm * 256 + wr * 64 + fr, col0 = u.pn * 256 + wc * 32 + fq * 8;
#pragma unroll
        for (int ai = 0; ai < 2; ++ai)
#pragma unroll
            for (int m = 0; m < 4; ++m) { const int row = row0 + ai * 128 + m * 16; float s = 0.f;
#pragma unroll
                for (int bj = 0; bj < 2; ++bj) { const size_t off = (size_t)row * DM + col0 + bj * 128;
                    const f32x4 h0 = *(const f32x4*)(base + off) + acc[ai][bj][m][0], h1 = *(const f32x4*)(base + off + 4) + acc[ai][bj][m][1];
                    u32x4 w; w.x = cvt_pk_bf16(h0[0], h0[1]); w.y = cvt_pk_bf16(h0[2], h0[3]); w.z = cvt_pk_bf16(h1[0], h1[1]); w.w = cvt_pk_bf16(h1[2], h1[3]);
                    *(u32x4*)(ob + off) = w; s += dot4(h0) + dot4(h1); }
                s += __shfl_xor(s, 16); s += __shfl_xor(s, 32);
                if (fq == 0) atomicAdd(ss + row, s);
                asm volatile("" ::: "memory"); }
    }
};
struct EpiDown {
    const bf16_t* hb; bf16_t* ob; float* ss;
    __device__ __forceinline__ void operator()(const f32x4 (&acc)[2][2][4][2], const Unit& u, int wr, int wc, int fr, int fq, LAS float*) const {
        const int row0 = u.pm * 256 + wr * 64 + fr, col0 = u.pn * 256 + wc * 32 + fq * 8;
#pragma unroll
        for (int ai = 0; ai < 2; ++ai)
#pragma unroll
            for (int m = 0; m < 4; ++m) { const int row = row0 + ai * 128 + m * 16; float s = 0.f;
#pragma unroll
                for (int bj = 0; bj < 2; ++bj) { const size_t off = (size_t)row * DM + col0 + bj * 128; const u32x4 hw = *(const u32x4*)(hb + off);
                    const f32x4 h0 = (f32x4){bf_lo(hw.x), bf_hi(hw.x), bf_lo(hw.y), bf_hi(hw.y)} + acc[ai][bj][m][0], h1 = (f32x4){bf_lo(hw.z), bf_hi(hw.z), bf_lo(hw.w), bf_hi(hw.w)} + acc[ai][bj][m][1];
                    u32x4 w; w.x = cvt_pk_bf16(h0[0], h0[1]); w.y = cvt_pk_bf16(h0[2], h0[3]); w.z = cvt_pk_bf16(h1[0], h1[1]); w.w = cvt_pk_bf16(h1[2], h1[3]);
                    *(u32x4*)(ob + off) = w; s += dot4(h0) + dot4(h1); }
                s += __shfl_xor(s, 16); s += __shfl_xor(s, 32);
                if (fq == 0) atomicAdd(ss + row, s);
                asm volatile("" ::: "memory"); }
    }
};
struct EpiProj {
    bf16_t* ob; float* ss;
    __device__ __forceinline__ void operator()(const f32x4 (&acc)[2][2][4][2], const Unit& u, int wr, int wc, int fr, int fq, LAS float*) const {
        const int row0 = u.pm * 256 + wr * 64 + fr, col0 = u.pn * 256 + wc * 32 + fq * 8;
#pragma unroll
        for (int ai = 0; ai < 2; ++ai)
#pragma unroll
            for (int m = 0; m < 4; ++m) { const int row = row0 + ai * 128 + m * 16; float s = 0.f;
#pragma unroll
                for (int bj = 0; bj < 2; ++bj) { const size_t off = (size_t)row * DM + col0 + bj * 128; const f32x4 h0 = acc[ai][bj][m][0], h1 = acc[ai][bj][m][1];
                    u32x4 w; w.x = cvt_pk_bf16(h0[0], h0[1]); w.y = cvt_pk_bf16(h0[2], h0[3]); w.z = cvt_pk_bf16(h1[0], h1[1]); w.w = cvt_pk_bf16(h1[2], h1[3]);
                    *(u32x4*)(ob + off) = w; s += dot4(h0) + dot4(h1); }
                s += __shfl_xor(s, 16); s += __shfl_xor(s, 32);
                if (fq == 0) atomicAdd(ss + row, s); }
    }
};
struct EpiGU {
    bf16_t* act; const float* ss;
    __device__ __forceinline__ void operator()(const f32x4 (&acc)[2][2][4][2], const Unit& u, int wr, int wc, int fr, int fq, LAS float*) const {
        const int row0 = u.pm * 256 + wr * 64 + fr, col0 = u.pn * 128 + wc * 32 + fq * 8;
#pragma unroll
        for (int ai = 0; ai < 2; ++ai)
#pragma unroll
            for (int m = 0; m < 4; ++m) { const int row = row0 + ai * 128 + m * 16; const float rs = __builtin_amdgcn_rsqf(ss[row] * (1.0f / DM) + EPS);
                float o[8];
#pragma unroll
                for (int n = 0; n < 2; ++n)
#pragma unroll
                    for (int j = 0; j < 4; ++j) { const float a = acc[ai][0][m][n][j] * rs, gg = acc[ai][1][m][n][j] * rs;
                        o[n * 4 + j] = a * __builtin_amdgcn_rcpf(1.0f + __expf(-a)) * gg; }
                u32x4 w; w.x = cvt_pk_bf16(o[0], o[1]); w.y = cvt_pk_bf16(o[2], o[3]); w.z = cvt_pk_bf16(o[4], o[5]); w.w = cvt_pk_bf16(o[6], o[7]);
                *(u32x4*)(act + (size_t)row * FF + col0) = w; }
    }
};
struct EpiGate {
    float* out; const bf16_t* hb; const bf16_t* eraw; const float* ss2; const float* ssE; const float* post;
    __device__ __forceinline__ void operator()(const f32x4 (&acc)[2][2][4][2], const Unit& u, int wr, int wc, int fr, int fq, LAS float*) const {
        const int row0 = u.pm * 256 + wr * 64 + fr, col0 = u.pn * 256 + wc * 32 + fq * 8;
#pragma unroll
        for (int ai = 0; ai < 2; ++ai)
#pragma unroll
            for (int m = 0; m < 4; ++m) { const int row = row0 + ai * 128 + m * 16;
                const float rs2 = __builtin_amdgcn_rsqf(ss2[row] * (1.0f / DM) + EPS), rsE = __builtin_amdgcn_rsqf(ssE[row] * (1.0f / DM) + EPS);
#pragma unroll
                for (int bj = 0; bj < 2; ++bj) { const size_t off = (size_t)row * DM + col0 + bj * 128;
                    const u32x4 ew = *(const u32x4*)(eraw + off); const f32x4 p0 = *(const f32x4*)(post + col0 + bj * 128), p1 = *(const f32x4*)(post + col0 + bj * 128 + 4);
                    const f32x4 e0 = (f32x4){bf_lo(ew.x), bf_hi(ew.x), bf_lo(ew.y), bf_hi(ew.y)} * rsE * p0, e1 = (f32x4){bf_lo(ew.z), bf_hi(ew.z), bf_lo(ew.w), bf_hi(ew.w)} * rsE * p1;
                    const u32x4 hw = *(const u32x4*)(hb + off);
                    f32x4 h0 = (f32x4){bf_lo(hw.x), bf_hi(hw.x), bf_lo(hw.y), bf_hi(hw.y)}, h1 = (f32x4){bf_lo(hw.z), bf_hi(hw.z), bf_lo(hw.w), bf_hi(hw.w)};
#pragma unroll
                    for (int j = 0; j < 4; ++j) { h0[j] += __builtin_amdgcn_rcpf(1.0f + __expf(-acc[ai][bj][m][0][j] * rs2)) * e0[j]; h1[j] += __builtin_amdgcn_rcpf(1.0f + __expf(-acc[ai][bj][m][1][j] * rs2)) * e1[j]; }
                    *(f32x4*)(out + off) = h0; *(f32x4*)(out + off + 4) = h1; }
                asm volatile("" ::: "memory"); }
    }
};

__device__ __forceinline__ void p0_transpose_blk(const float* W, const float* gain, int K, int N, bf16_t* WT, int gu, LAS unsigned char* T, int item) {
    const int tid = threadIdx.x, lane = tid & 63, w = __builtin_amdgcn_readfirstlane(tid >> 6);
    const int nblk = N / 256, kb = item / nblk, nb = item % nblk, k0 = 64 * kb, n0 = 256 * nb;
    f32x4 v[8];
#pragma unroll
    for (int i = 0; i < 8; ++i) v[i] = *(const f32x4*)(W + (size_t)(k0 + 8 * w + i) * N + n0 + 4 * lane);
    if (gain) {
#pragma unroll
        for (int i = 0; i < 8; ++i) v[i] *= gain[k0 + 8 * w + i]; }
#pragma unroll
    for (int j = 0; j < 4; ++j) { u32x4 o; o.x = cvt_pk_bf16(v[0][j], v[1][j]); o.y = cvt_pk_bf16(v[2][j], v[3][j]); o.z = cvt_pk_bf16(v[4][j], v[5][j]); o.w = cvt_pk_bf16(v[6][j], v[7][j]);
        *(LAS u32x4*)(T + (4 * lane + j) * 128 + ((w ^ (lane & 7)) * 16)) = o; }
    __syncthreads();
    int ndb = n0;
    if (gu) { const int s = n0 >= FF ? 1 : 0, j = n0 - s * FF; ndb = 256 * (j >> 7) + 128 * s; }
#pragma unroll
    for (int i = 0; i < 4; ++i) { const int id = tid + 512 * i, n = id >> 3, c = id & 7;
        const u32x4 o = *(const LAS u32x4*)(T + n * 128 + ((c ^ ((n >> 2) & 7)) * 16));
        const int nd = gu ? (ndb + 256 * (n >> 7) + (n & 127)) : (n0 + n);
        *(u32x4*)(WT + (size_t)nd * K + k0 + 8 * c) = o; }
    __syncthreads();
}
__device__ __forceinline__ float wave_sum(float v) {
#pragma unroll
    for (int o = 1; o < 64; o <<= 1) v += __shfl_xor(v, o);
    return v;
}
__device__ __forceinline__ int t5_bucket(int rel) {
    const int n = rel < 0 ? -rel : rel;
    int large = 8 + (int)(logf((float)(n < 1 ? 1 : n) / 8.0f) / logf(128.0f) * 8.0f);
    if (large > 15) large = 15;
    return (rel > 0 ? 16 : 0) + (n < 8 ? n : large);
}
__device__ __forceinline__ void p0_prologue(const Args& A, LAS unsigned char* lds) {
    const int tid = threadIdx.x, lane = tid & 63, wave = tid >> 6, G = gridDim.x, gw = blockIdx.x * 8 + wave, NGW = G * 8;
    unsigned char* ws = A.ws;
    {
        constexpr int I_IN = 32 * 24, I_OUT = 32 * 8, I_GU = 32 * 44, I_DN = 88 * 8, I_GT = 32 * 8, I_PJ = 4 * 8;
        constexpr int NIT = I_IN + I_OUT + I_GU + I_DN + I_GT + I_PJ;
        for (int it = blockIdx.x; it < NIT; it += G) {
            int r = it;
            if (r < I_IN) { p0_transpose_blk(A.in[4], A.in[3], DM, INW, (bf16_t*)(ws + WS_WIN), 0, lds, r); continue; } r -= I_IN;
            if (r < I_OUT) { p0_transpose_blk(A.in[19], nullptr, DM, DM, (bf16_t*)(ws + WS_WOUT), 0, lds, r); continue; } r -= I_OUT;
            if (r < I_GU) { p0_transpose_blk(A.in[21], A.in[20], DM, 2 * FF, (bf16_t*)(ws + WS_WGU), 1, lds, r); continue; } r -= I_GU;
            if (r < I_DN) { p0_transpose_blk(A.in[22], nullptr, FF, DM, (bf16_t*)(ws + WS_WDOWN), 0, lds, r); continue; } r -= I_DN;
            if (r < I_GT) { p0_transpose_blk(A.in[24], A.in[23], DM, DM, (bf16_t*)(ws + WS_WGATE), 0, lds, r); continue; } r -= I_GT;
            p0_transpose_blk(A.in[25], nullptr, PLE, DM, (bf16_t*)(ws + WS_WPROJ), 0, lds, r);
        }
    }
    {
        const float* x = A.in[0]; bf16_t* xb = (bf16_t*)(ws + WS_XB); float* rstd = (float*)(ws + WS_RSTDX);
        for (int m = gw; m < MTOK; m += NGW) {
            const f32x4* xr = (const f32x4*)(x + (size_t)m * DM) + lane; f32x4 v[8]; float s = 0.f;
#pragma unroll
            for (int j = 0; j < 8; ++j) { v[j] = xr[64 * j]; s += dot4(v[j]); }
            s = wave_sum(s);
            if (lane == 0) rstd[m] = 1.0f / sqrtf(s * (1.0f / DM) + EPS);
            u32x2* o = (u32x2*)(xb + (size_t)m * DM) + lane;
#pragma unroll
            for (int j = 0; j < 8; ++j) { u32x2 w; w.x = cvt_pk_bf16(v[j][0], v[j][1]); w.y = cvt_pk_bf16(v[j][2], v[j][3]); o[64 * j] = w; }
        }
    }
    {
        const size_t gt = (size_t)blockIdx.x * 512 + tid, NT = (size_t)G * 512;
        const f32x4* p4 = (const f32x4*)A.in[1]; u32x2* pb = (u32x2*)(ws + WS_PB);
        _Pragma("unroll 4") for (size_t i = gt; i < (size_t)MTOK * PLE / 4; i += NT) { const f32x4 v = p4[i]; u32x2 w; w.x = cvt_pk_bf16(v[0], v[1]); w.y = cvt_pk_bf16(v[2], v[3]); pb[i] = w; }
        float* z = (float*)(ws + WS_SSE);
        for (size_t i = gt; i < 3 * (size_t)MTOK; i += NT) z[i] = 0.f;
        if (blockIdx.x == 0) { unsigned* bw = (unsigned*)(ws + WS_BAR); for (int i = tid; i < 3456; i += 512) bw[i] = 0u;
            float* bt = (float*)(ws + WS_BTAB); const float* rb = A.in[2];
            for (int i = tid; i < 3 * 8 * 129; i += 512) { const int g = i / (8 * 129), h = (i / 129) % 8, rel = i % 129 - 64; const int d = g == 0 ? 1 : (g == 1 ? 4 : 16);
                bt[i] = rb[t5_bucket(rel * d) * 8 + h]; } }
    }
    {
        LAS float* zf = (LAS float*)lds;
        LAS float* hA = zf + 16 * 33;
        LAS float* hB = hA + 16 * 64;
        const float* w1 = A.in[9]; const float* b1 = A.in[10]; const float* wi = A.in[11]; const float* bi = A.in[12]; const float* wo = A.in[13];
        const float* fq = A.in[14]; const float* dec = A.in[15]; const float* hb = A.in[16];
        bf16_t* hr = (bf16_t*)(ws + WS_HR);
        __syncthreads();
        for (int z = blockIdx.x; z < 263; z += G) { const int q = z < 132 ? z : z + 257;
            for (int c = tid; c < HW; c += 512) { u32x4* d = (u32x4*)(hr + (size_t)c * HRLEN + 16 * q); d[0] = (u32x4){0u, 0u, 0u, 0u}; d[1] = (u32x4){0u, 0u, 0u, 0u}; } }
        for (int r = blockIdx.x; r < 256; r += G) {
            const bool edge = (r == 255);
#define FPOS(sl) (edge ? ((sl) < 15 ? 4095 - (sl) : 0) : (HROFF + 2048 - (16 * (133 + r) + (sl))))
            for (int t = tid; t < 16 * 33; t += 512) { const int pi = t / 33, f = t % 33; const float pos = (float)FPOS(pi); float v;
                if (f == 0) v = pos / 4095.0f;
                else { const int k = (f - 1) & 15; const float fr = 1e-4f + (float)k * ((15.0f - 1e-4f) / 15.0f); const float ang = ((float)(2.0 * 3.14159265358979323846 / 4096.0) * pos) * fr;
                    v = (f <= 16) ? cosf(ang) : -sinf(ang); }
                zf[t] = v; }
            __syncthreads();
#pragma unroll
            for (int h2 = 0; h2 < 2; ++h2) { const int e = tid + 512 * h2, pi = e >> 6, uu = e & 63; float sacc = b1[uu];
                _Pragma("unroll 11") for (int f = 0; f < 33; ++f) sacc += zf[pi * 33 + f] * w1[f * 64 + uu];
                hA[pi * 64 + uu] = sinf(fq[uu] * sacc); }
            __syncthreads();
#pragma unroll
            for (int h2 = 0; h2 < 2; ++h2) { const int e = tid + 512 * h2, pi = e >> 6, uu = e & 63; float sacc = bi[uu];
                _Pragma("unroll 4") for (int k4 = 0; k4 < 16; ++k4) { const f32x4 hv = *(const LAS f32x4*)(hA + pi * 64 + 4 * k4); sacc += (hv[0] * wi[(4 * k4) * 64 + uu] + hv[1] * wi[(4 * k4 + 1) * 64 + uu]) + (hv[2] * wi[(4 * k4 + 2) * 64 + uu] + hv[3] * wi[(4 * k4 + 3) * 64 + uu]); }
                hB[pi * 64 + uu] = sinf(fq[uu] * sacc); }
            __syncthreads();
#pragma unroll
            for (int h2 = 0; h2 < 2; ++h2) { const int e = tid + 512 * h2, pi = e >> 6, uu = e & 63; float sacc = bi[64 + uu];
                _Pragma("unroll 4") for (int k4 = 0; k4 < 16; ++k4) { const f32x4 hv = *(const LAS f32x4*)(hB + pi * 64 + 4 * k4); sacc += (hv[0] * wi[4096 + (4 * k4) * 64 + uu] + hv[1] * wi[4096 + (4 * k4 + 1) * 64 + uu]) + (hv[2] * wi[4096 + (4 * k4 + 2) * 64 + uu] + hv[3] * wi[4096 + (4 * k4 + 3) * 64 + uu]); }
                hA[pi * 64 + uu] = sinf(fq[uu] * sacc); }
            __syncthreads();
#pragma unroll 1
            for (int cc = 0; cc < 2; ++cc) { const int c = tid + 512 * cc; float a[16];
#pragma unroll
                for (int pi = 0; pi < 16; ++pi) a[pi] = 0.f;
                _Pragma("unroll 2") for (int k4 = 0; k4 < 16; ++k4) {
                    const float w0 = wo[(4 * k4 + 0) * HW + c], w1 = wo[(4 * k4 + 1) * HW + c], w2 = wo[(4 * k4 + 2) * HW + c], w3 = wo[(4 * k4 + 3) * HW + c];
#pragma unroll
                    for (int pi = 0; pi < 16; ++pi) { const f32x4 hv = *(const LAS f32x4*)(hA + pi * 64 + 4 * k4); a[pi] += (hv[0] * w0 + hv[1] * w1) + (hv[2] * w2 + hv[3] * w3); } }
                const float ad = fabsf(dec[c]);
#pragma unroll
                for (int pi = 0; pi < 16; ++pi) { const int p = FPOS(pi); const int ao = p >= 2048 ? p - 2048 : 2048 - p; const float offs = (float)ao * (1.0f / 2048.0f);
                    float v = a[pi] * expf(-offs * ad); if (p == 2048) v += hb[c]; a[pi] = v; }
                bf16_t* row = hr + (size_t)c * HRLEN;
                if (!edge) { u32x4* d = (u32x4*)(row + 16 * (133 + r));
                    d[0] = (u32x4){cvt_pk_bf16(a[0], a[1]), cvt_pk_bf16(a[2], a[3]), cvt_pk_bf16(a[4], a[5]), cvt_pk_bf16(a[6], a[7])};
                    d[1] = (u32x4){cvt_pk_bf16(a[8], a[9]), cvt_pk_bf16(a[10], a[11]), cvt_pk_bf16(a[12], a[13]), cvt_pk_bf16(a[14], a[15])}; }
                else { u32x4* dA = (u32x4*)(row + 2112); u32x4* dB = (u32x4*)(row + 6208);
                    dA[0] = (u32x4){cvt_pk_bf16(0.f, a[0]), cvt_pk_bf16(a[1], a[2]), cvt_pk_bf16(a[3], a[4]), cvt_pk_bf16(a[5], a[6])};
                    dA[1] = (u32x4){cvt_pk_bf16(a[7], a[8]), cvt_pk_bf16(a[9], a[10]), cvt_pk_bf16(a[11], a[12]), cvt_pk_bf16(a[13], a[14])};
                    dB[0] = (u32x4){cvt_pk_bf16(a[15], 0.f), 0u, 0u, 0u}; dB[1] = (u32x4){0u, 0u, 0u, 0u}; } }
            __syncthreads();
#undef FPOS
        }
    }
}

constexpr int KPITCH = 272, VPITCH = 288, AT_VS = 256 * KPITCH, AT_BT = AT_VS + 272 * VPITCH;
constexpr int ATT_ITEMS = 6144;
__device__ __forceinline__ void att_decode(int item, int& g, int& b, int& h, int& r, int& n0, int& dsh) {
    g = item >> 11; const int rem = item & 2047, bh = rem >> 5, sub = rem & 31; b = bh >> 3; h = bh & 7;
    dsh = g == 0 ? 0 : (g == 1 ? 2 : 4); const int psh = g == 0 ? 5 : (g == 1 ? 3 : 1);
    r = sub >> psh; n0 = 2 * (sub & ((1 << psh) - 1));
}
__device__ __forceinline__ void att_issue(const unsigned char* ws, int item, int tid, int wave, int lane, u32x4 (&pre)[16], bf16x8 (&qpre)[4], float& bpre, unsigned& vmask) {
    int g, b, h, r, n0, dsh; att_decode(item, g, b, h, r, n0, dsh);
    const int Ls = SEQ >> dsh, tokbase = b * SEQ;
    const bf16_t* Qp = (const bf16_t*)(ws + WS_Q); const bf16_t* Kp = (const bf16_t*)(ws + WS_K); const bf16_t* Vp = (const bf16_t*)(ws + WS_V);
    unsigned vm = 0u;
#pragma unroll
    for (int i = 0; i < 16; ++i) { const int c2 = (tid + 512 * i) & 4095, ki = c2 >> 4, cc = c2 & 15, idx = 64 * (n0 - 1) + ki;
        const bool ok = idx >= 0 && idx < Ls; const int pos = ((ok ? idx : 0) << dsh) + r;
        pre[i] = *(const u32x4*)((i < 8 ? Kp : Vp) + (size_t)(tokbase + pos) * AW + h * 128 + cc * 8);
        vm |= (ok ? 1u : 0u) << i; }
    vmask = vm;
    { const int qb = wave >> 2, t = wave & 3, idxq = 64 * (n0 + qb) + 16 * t + (lane & 15); const int tokq = tokbase + (idxq << dsh) + r;
        const bf16_t* qp = Qp + (size_t)tokq * AW + h * 128 + 8 * (lane >> 4);
#pragma unroll
        for (int kk = 0; kk < 4; ++kk) qpre[kk] = *(const bf16x8*)(qp + 32 * kk); }
    { const int bi = tid - 15; bpre = ((const float*)(ws + WS_BTAB))[(g * 8 + h) * 129 + (bi < 0 ? 0 : (bi > 128 ? 128 : bi))]; }
}
__device__ __forceinline__ void att_body(unsigned char* ws, LAS unsigned char* ks, LAS unsigned char* vs, LAS float* btab, int item, int nxt, int tid, int wave, int lane,
                                         u32x4 (&pre)[16], bf16x8 (&qpre)[4], float& bpre, unsigned& vmask) {
#pragma unroll
        for (int i = 0; i < 16; ++i) { const int c2 = (tid + 512 * i) & 4095, ki = c2 >> 4, cc = c2 & 15;
            u32x4 v = pre[i]; if (!((vmask >> i) & 1u)) v = (u32x4){0u, 0u, 0u, 0u};
            if (i < 8) *(LAS u32x4*)(ks + ki * KPITCH + cc * 16) = v; else *(LAS u32x4*)(vs + ki * VPITCH + cc * 16) = v; }
        if (tid < 160) btab[tid] = (tid >= 15 && tid <= 143) ? bpre : -1.0e30f;
        bf16x8 qf[4];
#pragma unroll
        for (int kk = 0; kk < 4; ++kk) qf[kk] = qpre[kk];
        asm volatile("s_waitcnt lgkmcnt(0)" ::: "memory"); __builtin_amdgcn_s_barrier(); asm volatile("" ::: "memory");
        att_issue(ws, nxt, tid, wave, lane, pre, qpre, bpre, vmask);
        {
            int g, b, h, r, n0, dsh; att_decode(item, g, b, h, r, n0, dsh);
            const int Ls = SEQ >> dsh, tokbase = b * SEQ;
            const int qb = wave >> 2, t = wave & 3, n = n0 + qb, l15 = lane & 15, rg = lane >> 4;
            const int tokq = tokbase + ((64 * n + 16 * t + l15) << dsh) + r;
            f32x4 S[9];
            const LAS unsigned char* kb = ks + (64 * qb + 16 * t + l15) * KPITCH + 16 * rg;
            bf16x8 kfa[9], kfb[9];
#pragma unroll
            for (int kt = 0; kt < 9; ++kt) { S[kt] = (f32x4){0.f, 0.f, 0.f, 0.f}; kfa[kt] = *(const LAS bf16x8*)(kb + (16 * kt) * KPITCH); }
#pragma unroll
            for (int kk = 0; kk < 4; ++kk) {
                if (kk < 3) {
#pragma unroll
                    for (int kt = 0; kt < 9; ++kt) { if (kk & 1) kfa[kt] = *(const LAS bf16x8*)(kb + (16 * kt) * KPITCH + 64 * (kk + 1)); else kfb[kt] = *(const LAS bf16x8*)(kb + (16 * kt) * KPITCH + 64 * (kk + 1)); } }
#pragma unroll
                for (int kt = 0; kt < 9; ++kt) S[kt] = __builtin_amdgcn_mfma_f32_16x16x32_bf16((kk & 1) ? kfb[kt] : kfa[kt], qf[kk], S[kt], 0, 0, 0);
            }
            float mx = -3.0e38f;
            const int idxk0 = 64 * (n - 1) + 16 * t + 4 * rg;
            const LAS float* tb = btab + (4 * rg - l15 + 15);
#pragma unroll
            for (int kt = 0; kt < 9; ++kt)
#pragma unroll
                for (int j = 0; j < 4; ++j) { const int idxk = idxk0 + 16 * kt + j;
                    const float pen = (idxk >= 0 && idxk < Ls) ? 0.f : -1.0e30f;
                    const float sv = fmaxf((S[kt][j] + tb[16 * kt + j]) + pen, -1.0e30f);
                    S[kt][j] = sv; mx = fmaxf(mx, sv); }
            mx = fmaxf(mx, __shfl_xor(mx, 16)); mx = fmaxf(mx, __shfl_xor(mx, 32));
            float lsum = 0.f; bf16x8 pf[5];
#pragma unroll
            for (int ksx = 0; ksx < 5; ++ksx) { float e[8];
#pragma unroll
                for (int j = 0; j < 4; ++j) { e[j] = __expf(S[2 * ksx][j] - mx); e[4 + j] = (2 * ksx + 1 < 9) ? __expf(S[(2 * ksx + 1 < 9) ? 2 * ksx + 1 : 8][j] - mx) : 0.f; }
#pragma unroll
                for (int j = 0; j < 8; ++j) lsum += e[j];
                u32x4 w; w.x = cvt_pk_bf16(e[0], e[1]); w.y = cvt_pk_bf16(e[2], e[3]); w.z = cvt_pk_bf16(e[4], e[5]); w.w = cvt_pk_bf16(e[6], e[7]);
                pf[ksx] = __builtin_bit_cast(bf16x8, w); }
            lsum += __shfl_xor(lsum, 16); lsum += __shfl_xor(lsum, 32);
            f32x4 O[8];
#pragma unroll
            for (int ct = 0; ct < 8; ++ct) O[ct] = (f32x4){0.f, 0.f, 0.f, 0.f};
            const LAS unsigned char* vb = vs + (64 * qb + 16 * t + 4 * rg + (l15 >> 2)) * VPITCH + 64 * (lane & 3);
#pragma unroll
            for (int ksx = 0; ksx < 5; ++ksx)
#pragma unroll
                for (int ct = 0; ct < 8; ++ct) {
                    const s16x4 lo = __builtin_amdgcn_ds_read_tr16_b64_v4i16((LAS s16x4*)(vb + (32 * ksx) * VPITCH + 8 * ct));
                    const s16x4 hi = __builtin_amdgcn_ds_read_tr16_b64_v4i16((LAS s16x4*)(vb + (32 * ksx + 16) * VPITCH + 8 * ct));
                    const bf16x8 vf = __builtin_shufflevector(lo, hi, 0, 1, 2, 3, 4, 5, 6, 7);
                    O[ct] = __builtin_amdgcn_mfma_f32_16x16x32_bf16(vf, pf[ksx], O[ct], 0, 0, 0); }
            bf16_t* op = (bf16_t*)(ws + WS_OG) + ((size_t)g * MTOK + tokq) * AW + h * 128 + 32 * rg; const float inv = 1.0f / lsum;
#pragma unroll
            for (int c2 = 0; c2 < 4; ++c2) { const f32x4 o0 = O[2 * c2] * inv, o1 = O[2 * c2 + 1] * inv;
                u32x4 w; w.x = cvt_pk_bf16(o0[0], o0[1]); w.y = cvt_pk_bf16(o0[2], o0[3]); w.z = cvt_pk_bf16(o1[0], o1[1]); w.w = cvt_pk_bf16(o1[2], o1[3]); *(u32x4*)(op + 8 * c2) = w; }
            ((float*)(ws + WS_LSE))[((size_t)g * MTOK + tokq) * 8 + h] = mx + __logf(lsum);
        }
        asm volatile("s_waitcnt lgkmcnt(0)" ::: "memory"); __builtin_amdgcn_s_barrier(); asm volatile("" ::: "memory");
}
__device__ __forceinline__ void attn_phase(const Args& A, LAS unsigned char* lds) {
    const int tid = threadIdx.x, lane = tid & 63, wave = __builtin_amdgcn_readfirstlane(tid >> 6), G = gridDim.x;
    unsigned char* ws = A.ws;
    LAS unsigned char* ks = lds; LAS unsigned char* vs = lds + AT_VS; LAS float* btab = (LAS float*)(lds + AT_BT);
    if (tid < 288) *(LAS u32x4*)(vs + 256 * VPITCH + tid * 16) = (u32x4){0u, 0u, 0u, 0u};
    u32x4 pre[16]; bf16x8 qpre[4]; float bpre; unsigned vmask;
    const bool xmap = (G == 256);
    const int per = xmap ? 24 : (ATT_ITEMS + G - 1) / G;
    const int ibase = blockIdx.x * per, nit = xmap ? 24 : ((ibase + per) < ATT_ITEMS ? per : (ATT_ITEMS - ibase > 0 ? ATT_ITEMS - ibase : 0));
#define ATT_MAP(i) (xmap ? (((((3 * (int)(blockIdx.x >> 3) + (i) % 3) >> 5) << 11) | (((int)(blockIdx.x & 7) + 8 * ((i) / 3)) << 5) | ((3 * (int)(blockIdx.x >> 3) + (i) % 3) & 31))) : (ibase + (i)))
    if (nit > 0) {
        int item = ATT_MAP(0);
        att_issue(ws, item, tid, wave, lane, pre, qpre, bpre, vmask);
        { const int nxt = ATT_MAP(1 < nit ? 1 : 0); att_body(ws, ks, vs, btab, item, nxt, tid, wave, lane, pre, qpre, bpre, vmask); item = nxt; }
        for (int ii = 1; ii < nit; ++ii) { const int nxt = ATT_MAP(ii + 1 < nit ? ii + 1 : ii); att_body(ws, ks, vs, btab, item, nxt, tid, wave, lane, pre, qpre, bpre, vmask); item = nxt; }
    }
#undef ATT_MAP
    __syncthreads();
}

__device__ __forceinline__ float bf_el(u32x2 r, int ch) { return ch == 0 ? bf_lo(r.x) : (ch == 1 ? bf_hi(r.x) : (ch == 2 ? bf_lo(r.y) : bf_hi(r.y))); }
__device__ __forceinline__ void sconv_phase(const Args& A) {
    const int tid = threadIdx.x, lane = tid & 63, wave = tid >> 6, gw = blockIdx.x * 8 + wave, NGW = gridDim.x * 8; unsigned char* ws = A.ws;
    const bf16_t* HY = (const bf16_t*)(ws + WS_HY); const float* cw = A.in[7]; const float* cb = A.in[8];
    bf16_t* zt = (bf16_t*)(ws + WS_ZT); bf16_t* x0t = (bf16_t*)(ws + WS_X0T);
    const int b = lane >> 3, cgp = lane & 7;
    const bool xmap = (gridDim.x == 256);
    const int wid = (int)(blockIdx.x >> 3) * 8 + wave;
    for (int it = 0; it < (xmap ? 8 : (32 * 512 + NGW - 1) / NGW); ++it) {
        const int id = xmap ? ((8 * ((int)(blockIdx.x & 7) + 8 * it) + (wid >> 5)) * 32 + (wid & 31)) : (gw + NGW * it);
        if (id >= 32 * 512) break;
        const int ct = id & 31, q = id >> 5, c0 = 32 * ct + 4 * cgp, j0 = 8 * q;
        f32x4 w[3][3], bs[3];
#pragma unroll
        for (int s = 0; s < 3; ++s) { bs[s] = *(const f32x4*)(cb + s * 1024 + c0);
#pragma unroll
            for (int t = 0; t < 3; ++t) w[s][t] = *(const f32x4*)(cw + t * 3072 + s * 1024 + c0); }
        u32x2 rows[10][3];
#pragma unroll
        for (int rr = 0; rr < 10; ++rr) { const int js = j0 - 1 + rr; const bool ok = js >= 0 && js < SEQ; const bf16_t* rp = HY + (size_t)(b * SEQ + (ok ? js : 0)) * 3072 + c0;
#pragma unroll
            for (int s = 0; s < 3; ++s) { u32x2 v = *(const u32x2*)(rp + s * 1024); if (!ok) v = (u32x2){0u, 0u}; rows[rr][s] = v; } }
        unsigned ox[4][4], oz[4][4]; float px[4], pz[4];
#pragma unroll
        for (int jj = 0; jj < 8; ++jj) {
#pragma unroll
            for (int ch = 0; ch < 4; ++ch) { float v[3];
#pragma unroll
                for (int s = 0; s < 3; ++s) v[s] = bs[s][ch] + w[s][0][ch] * bf_el(rows[jj][s], ch) + w[s][1][ch] * bf_el(rows[jj + 1][s], ch) + w[s][2][ch] * bf_el(rows[jj + 2][s], ch);
                const float x0 = v[0], z = v[2] * v[1];
                if (jj & 1) { ox[ch][jj >> 1] = cvt_pk_bf16(px[ch], x0); oz[ch][jj >> 1] = cvt_pk_bf16(pz[ch], z); } else { px[ch] = x0; pz[ch] = z; } } }
#pragma unroll
        for (int ch = 0; ch < 4; ++ch) { const size_t dst = ((size_t)(c0 + ch) * 512 + q) * 64 + b * 8;
            *(u32x4*)(x0t + dst) = (u32x4){ox[ch][0], ox[ch][1], ox[ch][2], ox[ch][3]}; *(u32x4*)(zt + dst) = (u32x4){oz[ch][0], oz[ch][1], oz[ch][2], oz[ch][3]}; }
    }
}

__device__ __forceinline__ void lconv_item(const Args& A, LAS unsigned char* lds, int c) {
    const int tid = threadIdx.x, lane = tid & 63, wave = __builtin_amdgcn_readfirstlane(tid >> 6); unsigned char* ws = A.ws;
    LAS unsigned char* zs = lds; LAS unsigned char* hA = lds + 70144; LAS unsigned char* hB = hA + 16640;
    { const u32x4* zsrc = (const u32x4*)((const bf16_t*)(ws + WS_ZT) + (size_t)c * 32768);
        for (int ch = tid; ch < 4096; ch += 512) *(LAS u32x4*)(zs + 256 + ch * 16) = zsrc[ch];
        if (tid < 16) *(LAS u32x4*)(zs + tid * 16) = (u32x4){0u, 0u, 0u, 0u};
        if (tid >= 64 && tid < 336) *(LAS u32x4*)(zs + 65792 + (tid - 64) * 16) = (u32x4){0u, 0u, 0u, 0u};
        const u32x4* hsrc = (const u32x4*)((const bf16_t*)(ws + WS_HR) + (size_t)c * HRLEN);
        for (int ch = tid; ch < 1040; ch += 512) *(LAS u32x4*)(hA + ch * 16) = hsrc[ch]; }
    __syncthreads();
    for (int k = tid; k < 4160; k += 512) { const unsigned lo = ((const LAS unsigned*)hA)[k], hi = (k + 1 < 4160) ? ((const LAS unsigned*)hA)[k + 1] : 0u; ((LAS unsigned*)hB)[k] = (lo >> 16) | (hi << 16); }
    __syncthreads();
    {
        const int m = lane & 15, gq = lane >> 4;
        const LAS unsigned char* tbase = ((m & 1) ? (hB - 2) : hA) + 2 * (4144 + 8 * gq - m);
        const int bb = m & 7, sh = m >> 3;
        const LAS unsigned char* zbase = zs + ((2 * sh + gq) * 8 + bb) * 16;
        const bf16_t* x0t = (const bf16_t*)(ws + WS_X0T) + (size_t)c * 32768; bf16_t* yt = (bf16_t*)(ws + WS_YT) + (size_t)c * 32768;
#pragma unroll 1
        for (int ib = 0; ib < 2; ++ib) {
            const int It0 = 16 * wave + 8 * ib;
            const int jlo = (It0 - 64) > 0 ? (It0 - 64) : 0, jhi = (It0 + 71) < 128 ? (It0 + 71) : 128;
            const int elo = jlo - It0, nch = (jhi - jlo + 8) >> 3;
            const LAS unsigned char* tp = tbase + 64 * elo; const LAS unsigned char* zp = zbase + 512 * jlo;
            f32x4 acc[8]; bf16x8 R[8];
#pragma unroll
            for (int p = 0; p < 8; ++p) acc[p] = (f32x4){0.f, 0.f, 0.f, 0.f};
            R[0] = (bf16x8){0, 0, 0, 0, 0, 0, 0, 0};
#pragma unroll
            for (int k = 1; k < 8; ++k) R[k] = __builtin_bit_cast(bf16x8, *(const LAS u32x4_a4*)(tp + 64 * (k - 8)));
#pragma unroll 1
            for (int chn = 0; chn < nch; ++chn) {
#pragma unroll
                for (int k = 0; k < 8; ++k) {
                    R[k] = __builtin_bit_cast(bf16x8, *(const LAS u32x4_a4*)(tp + 64 * k));
                    const bf16x8 zf = *(const LAS bf16x8*)(zp + 512 * k);
#pragma unroll
                    for (int p = 0; p < 8; ++p) acc[p] = __builtin_amdgcn_mfma_f32_16x16x32_bf16(R[(k - p) & 7], zf, acc[p], 0, 0, 0); }
                tp += 512; zp += 4096; }
#pragma unroll
            for (int p = 0; p < 8; ++p) { const int q = 4 * (It0 + p) + 2 * sh + (gq >> 1); const size_t off = (size_t)(q * 8 + bb) * 8 + 4 * (gq & 1);
                const u32x2 xw = *(const u32x2*)(x0t + off);
                u32x2 w; w.x = cvt_pk_bf16(acc[p][0] * bf_lo(xw.x), acc[p][1] * bf_hi(xw.x)); w.y = cvt_pk_bf16(acc[p][2] * bf_lo(xw.y), acc[p][3] * bf_hi(xw.y));
                *(u32x2*)(yt + off) = w; }
        }
    }
    __syncthreads();
}

__device__ __forceinline__ void merge_attn(const Args& A) {
    const int tid = threadIdx.x, lane = tid & 63, wave = tid >> 6, gw = blockIdx.x * 8 + wave, NGW = gridDim.x * 8; unsigned char* ws = A.ws;
    const bf16_t* og = (const bf16_t*)(ws + WS_OG); const float* lse = (const float*)(ws + WS_LSE); bf16_t* y = (bf16_t*)(ws + WS_Y); const float* gain = A.in[17];
    const int head = lane >> 3, col = lane * 16;
    f32x4 gn[4];
#pragma unroll
    for (int k = 0; k < 4; ++k) gn[k] = *(const f32x4*)(gain + col + 4 * k);
    for (int tok = gw; tok < MTOK; tok += NGW) {
        float l[3], mxl = -3.0e38f;
#pragma unroll
        for (int g = 0; g < 3; ++g) { l[g] = lse[((size_t)g * MTOK + tok) * 8 + head]; mxl = fmaxf(mxl, l[g]); }
        float wsum = 0.f;
#pragma unroll
        for (int g = 0; g < 3; ++g) { l[g] = __expf(l[g] - mxl); wsum += l[g]; }
        const float iw = 1.0f / wsum; float v[16];
#pragma unroll
        for (int k = 0; k < 16; ++k) v[k] = 0.f;
#pragma unroll
        for (int g = 0; g < 3; ++g) { const float wg = l[g] * iw; const u32x4* src = (const u32x4*)(og + ((size_t)g * MTOK + tok) * AW + col);
#pragma unroll
            for (int k = 0; k < 2; ++k) { const u32x4 t = src[k];
                v[8 * k + 0] += wg * bf_lo(t.x); v[8 * k + 1] += wg * bf_hi(t.x); v[8 * k + 2] += wg * bf_lo(t.y); v[8 * k + 3] += wg * bf_hi(t.y);
                v[8 * k + 4] += wg * bf_lo(t.z); v[8 * k + 5] += wg * bf_hi(t.z); v[8 * k + 6] += wg * bf_lo(t.w); v[8 * k + 7] += wg * bf_hi(t.w); } }
        float ss = 0.f;
#pragma unroll
        for (int k = 0; k < 16; ++k) ss += v[k] * v[k];
        ss += __shfl_xor(ss, 1); ss += __shfl_xor(ss, 2); ss += __shfl_xor(ss, 4);
        const float r = 1.0f / sqrtf(ss * (1.0f / 128.0f) + EPS);
        u32x4 o0, o1;
        o0.x = cvt_pk_bf16(v[0] * r * gn[0][0], v[1] * r * gn[0][1]); o0.y = cvt_pk_bf16(v[2] * r * gn[0][2], v[3] * r * gn[0][3]);
        o0.z = cvt_pk_bf16(v[4] * r * gn[1][0], v[5] * r * gn[1][1]); o0.w = cvt_pk_bf16(v[6] * r * gn[1][2], v[7] * r * gn[1][3]);
        o1.x = cvt_pk_bf16(v[8] * r * gn[2][0], v[9] * r * gn[2][1]); o1.y = cvt_pk_bf16(v[10] * r * gn[2][2], v[11] * r * gn[2][3]);
        o1.z = cvt_pk_bf16(v[12] * r * gn[3][0], v[13] * r * gn[3][1]); o1.w = cvt_pk_bf16(v[14] * r * gn[3][2], v[15] * r * gn[3][3]);
        u32x4* dst = (u32x4*)(y + (size_t)tok * DM + col); dst[0] = o0; dst[1] = o1;
    }
}
__device__ __forceinline__ void hynorm_phase(const Args& A) {
    const int tid = threadIdx.x, lane = tid & 63, b = tid >> 6, G = gridDim.x; unsigned char* ws = A.ws;
    const bf16_t* yt = (const bf16_t*)(ws + WS_YT); bf16_t* y = (bf16_t*)(ws + WS_Y); const float* gp = A.in[18];
    for (int item = blockIdx.x; item < 4096; item += 2 * G) {
        const int item2 = (item + G) < 4096 ? (item + G) : item;
        u32x4 v[2][2]; int grp[2], q[2];
#pragma unroll
        for (int k = 0; k < 2; ++k) { const int it = k ? item2 : item; grp[k] = it >> 9; q[k] = it & 511;
            const bf16_t* src = yt + ((size_t)(grp[k] * 128 + 2 * lane) * 512 + q[k]) * 64 + b * 8;
            v[k][0] = *(const u32x4*)src; v[k][1] = *(const u32x4*)(src + 512 * 64); }
#pragma unroll
        for (int k = 0; k < 2; ++k) {
            const int c0 = grp[k] * 128 + 2 * lane; const float g0 = gp[c0], g1 = gp[c0 + 1];
            float a[8], c[8], ss[8];
            a[0] = bf_lo(v[k][0].x); a[1] = bf_hi(v[k][0].x); a[2] = bf_lo(v[k][0].y); a[3] = bf_hi(v[k][0].y); a[4] = bf_lo(v[k][0].z); a[5] = bf_hi(v[k][0].z); a[6] = bf_lo(v[k][0].w); a[7] = bf_hi(v[k][0].w);
            c[0] = bf_lo(v[k][1].x); c[1] = bf_hi(v[k][1].x); c[2] = bf_lo(v[k][1].y); c[3] = bf_hi(v[k][1].y); c[4] = bf_lo(v[k][1].z); c[5] = bf_hi(v[k][1].z); c[6] = bf_lo(v[k][1].w); c[7] = bf_hi(v[k][1].w);
#pragma unroll
            for (int i = 0; i < 8; ++i) ss[i] = a[i] * a[i] + c[i] * c[i];
#pragma unroll
            for (int o = 1; o < 64; o <<= 1)
#pragma unroll
                for (int i = 0; i < 8; ++i) ss[i] += __shfl_xor(ss[i], o);
            bf16_t* dst = y + (size_t)(b * SEQ + 8 * q[k]) * DM + 1024 + c0;
#pragma unroll
            for (int i = 0; i < 8; ++i) { const float r = 1.0f / sqrtf(ss[i] * (1.0f / 128.0f) + EPS);
                *(unsigned*)(dst + (size_t)i * DM) = cvt_pk_bf16(a[i] * r * g0, c[i] * r * g1); }
        }
    }
}

#define XB_TMO      128
#define XB_XCNT(j)  (256  + 64 * (j))
#define XB_XSUB(j)  (1280 + 64 * (j))
#define XB_XGEN(j)  (2304 + 64 * (j))
#define XB_TOP      3328
#define XB_TOPGEN   3392
#define XCD_BAR_WORDS 3456
#define XB_SPIN_CAP (1u << 18)
__device__ __forceinline__ unsigned xb_ld(unsigned* p)              { return __hip_atomic_load(p, __ATOMIC_RELAXED, __HIP_MEMORY_SCOPE_AGENT); }
__device__ __forceinline__ unsigned xb_add(unsigned* p, unsigned v) { return __hip_atomic_fetch_add(p, v, __ATOMIC_RELAXED, __HIP_MEMORY_SCOPE_AGENT); }
__device__ __forceinline__ unsigned xb_xcc_id() { return (unsigned)__builtin_amdgcn_s_getreg((3 << 11) | 20) & 0xFu; }
#define XB_SPIN(cond, bar) do { unsigned _sp = 0; while (cond) { __builtin_amdgcn_s_sleep(1); \
    if ((++_sp & 255u) == 0u) { if (xb_ld(&(bar)[XB_TMO])) break; if (_sp > XB_SPIN_CAP) { atomicAdd(&(bar)[XB_TMO], 1u); break; } } } } while (0)
struct XcdBarrier { unsigned* bar; unsigned x; volatile LAS unsigned* st; };
__device__ __forceinline__ XcdBarrier xcd_barrier_post(unsigned* bar, volatile LAS unsigned* st) {
    XcdBarrier b; b.bar = bar; b.x = xb_xcc_id(); b.st = st;
    if (threadIdx.x == 0) (void)xb_add(&bar[XB_XCNT(b.x)], 1u);
    return b;
}
__device__ __forceinline__ void xcd_barrier_complete(unsigned* bar, unsigned x, unsigned& nloc, unsigned& nx) {
    const unsigned G = gridDim.x * gridDim.y * gridDim.z;
    unsigned sum, cnt, mine, sp = 0u;
    for (;;) {
        sum = 0u; cnt = 0u; mine = 0u;
#pragma unroll
        for (unsigned j = 0; j < 16; ++j) { const unsigned c = xb_ld(&bar[XB_XCNT(j)]); sum += c; cnt += (c > 0u) ? 1u : 0u; mine = (j == x) ? c : mine; }
        if (sum == G) break;
        __builtin_amdgcn_s_sleep(1);
        if ((++sp & 255u) == 0u) { if (xb_ld(&bar[XB_TMO])) break; if (sp > XB_SPIN_CAP) { atomicAdd(&bar[XB_TMO], 1u); break; } }
    }
    nloc = mine > 0u ? mine : 1u; nx = cnt > 0u ? cnt : 1u;
}
__device__ __forceinline__ void xcd_barrier(const XcdBarrier& b) {
    asm volatile("s_waitcnt vmcnt(0)" ::: "memory");
    __syncthreads();
    if (threadIdx.x == 0) {
        unsigned* bar = b.bar;
        __builtin_amdgcn_s_waitcnt(0);
        unsigned nloc = b.st[0], nx = b.st[1];
        if (nloc == 0u) { xcd_barrier_complete(bar, b.x, nloc, nx); b.st[0] = nloc; b.st[1] = nx; }
        const unsigned old = xb_add(&bar[XB_XSUB(b.x)], 1u);
        const unsigned gen = old / nloc;
        if (old + 1u == (gen + 1u) * nloc) {
            __builtin_amdgcn_fence(__ATOMIC_RELEASE, "agent");
            asm volatile("s_waitcnt vmcnt(0)" ::: "memory");
            const unsigned og = xb_add(&bar[XB_TOP], 1u);
            const unsigned tg = og / nx;
            if (og + 1u == (tg + 1u) * nx) xb_add(&bar[XB_TOPGEN], 1u);
            else XB_SPIN(xb_ld(&bar[XB_TOPGEN]) == tg, bar);
            __builtin_amdgcn_fence(__ATOMIC_ACQUIRE, "agent");
            xb_add(&bar[XB_XGEN(b.x)], 1u);
            asm volatile("s_waitcnt vmcnt(0)" ::: "memory");
        } else {
            XB_SPIN(xb_ld(&bar[XB_XGEN(b.x)]) == gen, bar);
            __builtin_amdgcn_fence(__ATOMIC_ACQUIRE, "agent");
            asm volatile("s_waitcnt vmcnt(0)" ::: "memory");
        }
    }
    __syncthreads();
}

__global__ void __launch_bounds__(512, 2) fwd_mega(Args args) {
    extern __shared__ __attribute__((aligned(16))) unsigned char lds_raw[];
    LAS unsigned char* lds = (LAS unsigned char*)lds_raw;
    LAS float* xl = (LAS float*)(lds + XL_OFF);
    const int lo = args.ph_lo, hi = args.ph_hi, G = gridDim.x;
    unsigned char* ws = args.ws;
    volatile LAS unsigned* bst = (volatile LAS unsigned*)(lds + BARST_OFF);
    if (threadIdx.x < 2) bst[threadIdx.x] = 0u;
    __syncthreads();
    XcdBarrier xbar; xbar.bar = (unsigned*)(ws + WS_BAR); xbar.x = 0; xbar.st = bst;
    if (args.ph_lo > 0) xbar = xcd_barrier_post((unsigned*)(ws + WS_BAR), bst);
#ifndef DUPMASK
#define DUPMASK 0
#endif
#define IN(k) (lo <= (k) && (k) < hi)
#define REP(k) for (int rep_ = 0; rep_ < (((DUPMASK >> (k)) & 1) ? 2 : 1); ++rep_, (rep_ < 2 && ((DUPMASK >> (k)) & 1)) ? cg::this_grid().sync() : (void)0)
#define SEAM(k) do { if (IN(k) && IN((k) + 1)) { if ((k) == 0) cg::this_grid().sync(); else xcd_barrier(xbar); } } while (0)
    if (IN(0)) REP(0) { p0_prologue(args, lds); } SEAM(0);
    if (args.ph_lo == 0) xbar = xcd_barrier_post((unsigned*)(ws + WS_BAR), bst);
    if (IN(1)) { pg8::Gemm g{(const bf16_t*)(ws + WS_XB), (const bf16_t*)(ws + WS_WIN), MTOK, INW, DM}; pg8::StaticOrder S; S.init(MTOK, INW, G, (int)blockIdx.x);
        EpiIn E{ws, args.in[5], args.in[6]}; pg8::gemm_phase(lds, xl, g, S, E); } SEAM(1);
    if (IN(2)) REP(2) { attn_phase(args, lds);
        sconv_phase(args); } SEAM(2);
    if (IN(3)) REP(3) { for (int c = blockIdx.x; c < HW; c += G) lconv_item(args, lds, c); } SEAM(3);
    if (IN(4)) REP(4) { merge_attn(args); hynorm_phase(args); } SEAM(4);
    if (IN(5)) { { pg8::Gemm g{(const bf16_t*)(ws + WS_Y), (const bf16_t*)(ws + WS_WOUT), MTOK, DM, DM}; pg8::StaticOrder S; S.init(MTOK, DM, G, (int)blockIdx.x);
            EpiOut E{args.in[0], (bf16_t*)(ws + WS_H1B), (float*)(ws + WS_SS1)}; pg8::gemm_phase(lds, xl, g, S, E); }
        { pg8::Gemm g{(const bf16_t*)(ws + WS_PB), (const bf16_t*)(ws + WS_WPROJ), MTOK, DM, PLE}; pg8::StaticOrder S; S.init(MTOK, DM, G, (int)blockIdx.x);
            EpiProj E{(bf16_t*)(ws + WS_ERAW), (float*)(ws + WS_SSE)}; pg8::gemm_phase(lds, xl, g, S, E); } } SEAM(5);
    if (IN(6)) { pg8::Gemm g{(const bf16_t*)(ws + WS_H1B), (const bf16_t*)(ws + WS_WGU), MTOK, 2 * FF, DM}; pg8::StaticOrder S; S.init(MTOK, 2 * FF, G, (int)blockIdx.x);
        EpiGU E{(bf16_t*)(ws + WS_ACT), (const float*)(ws + WS_SS1)}; pg8::gemm_phase(lds, xl, g, S, E); } SEAM(6);
    if (IN(7)) { pg8::Gemm g{(const bf16_t*)(ws + WS_ACT), (const bf16_t*)(ws + WS_WDOWN), MTOK, DM, FF}; pg8::StaticOrder S; S.init(MTOK, DM, G, (int)blockIdx.x);
        EpiDown E{(const bf16_t*)(ws + WS_H1B), (bf16_t*)(ws + WS_H2B), (float*)(ws + WS_SS2)}; pg8::gemm_phase(lds, xl, g, S, E); } SEAM(7);
    if (IN(8)) { pg8::Gemm g{(const bf16_t*)(ws + WS_H2B), (const bf16_t*)(ws + WS_WGATE), MTOK, DM, DM}; pg8::StaticOrder S; S.init(MTOK, DM, G, (int)blockIdx.x);
        EpiGate E{args.out, (const bf16_t*)(ws + WS_H2B), (const bf16_t*)(ws + WS_ERAW), (const float*)(ws + WS_SS2), (const float*)(ws + WS_SSE), args.in[26]}; pg8::gemm_phase(lds, xl, g, S, E); }
#undef IN
#undef SEAM
}

extern "C" void kernel_launch(void* const* d_in, const int* in_sizes, int n_in, void* d_out, int out_size, void* d_ws, size_t ws_size, hipStream_t stream) {
    static int grid = 0;
    if (grid == 0) {
        if (n_in != 27 || out_size != MTOK * DM || ws_size < WS_END) { fprintf(stderr, "kernel_launch: unexpected shapes (n_in %d out %d ws %zu)\n", n_in, out_size, ws_size); grid = -1; return; }
        int dev = 0, cus = 0, per_cu = 0;
        (void)hipGetDevice(&dev); (void)hipDeviceGetAttribute(&cus, hipDeviceAttributeMultiprocessorCount, dev);
        if (hipFuncSetAttribute((const void*)fwd_mega, hipFuncAttributeMaxDynamicSharedMemorySize, LDS_BYTES) != hipSuccess) { fprintf(stderr, "kernel_launch: hipFuncSetAttribute failed\n"); grid = -1; return; }
        if (hipOccupancyMaxActiveBlocksPerMultiprocessor(&per_cu, (const void*)fwd_mega, 512, LDS_BYTES) != hipSuccess || per_cu < 1) { fprintf(stderr, "kernel_launch: occupancy query says %d\n", per_cu); per_cu = 1; }
        (void)hipGetLastError();
        grid = cus * per_cu;
    }
    if (grid < 0) return;
    Args a{};
    for (int i = 0; i < 27; ++i) a.in[i] = (const float*)d_in[i];
    a.out = (float*)d_out; a.ws = (unsigned char*)d_ws;
#if ONE_LAUNCH
    a.ph_lo = 0; a.ph_hi = NPH;
    void* kargs[] = {&a};
    hipError_t e = hipLaunchCooperativeKernel((const void*)fwd_mega, dim3(grid), dim3(512), kargs, LDS_BYTES, stream);
    if (e != hipSuccess) fprintf(stderr, "kernel_launch: cooperative launch failed: %s (grid %d)\n", hipGetErrorString(e), grid);
#else
    for (int ph = 0; ph < NPH; ++ph) { a.ph_lo = ph; a.ph_hi = ph + 1; hipLaunchKernelGGL(fwd_mega, dim3(grid), dim3(512), LDS_BYTES, stream, a); }
#endif
}
```
